# Optimizing an MI355X kernel written in HIP

```python
import jax, jax.numpy as jnp
from jax import lax
import numpy as np

D_MODEL = 1024
BATCH = 4
SEQ = 4096
DEPTH = 2
DEC_BATCH = 32
DEC_SEQ = 64
PAST_LEN = 2048

CHUNK = 64
N_EVEN = (DEPTH + 1) // 2
N_ODD = DEPTH // 2
A_HEADS = 8
A_HEAD_DIM = 64
A_WIDTH = A_HEADS * A_HEAD_DIM
Q_BLOCK = 2 * CHUNK
B_WIDTH = D_MODEL // 2
B_BLOCKS = 8
B_BLOCK_DIM = B_WIDTH // B_BLOCKS
RG_CONV = 4
RG_C = 8.0
E_SPLITS = (A_WIDTH, 2 * A_WIDTH, 3 * A_WIDTH, 3 * A_WIDTH + A_HEADS, 3 * A_WIDTH + A_HEADS + B_WIDTH)
E_COLS = 3 * A_WIDTH + A_HEADS + 2 * B_WIDTH
C_WIDTH = D_MODEL
C_GROUPS = 8
C_GROUP_DIM = C_WIDTH // C_GROUPS
C_LEN = 2 * CHUNK
D_FF = 2816
FFN_CONV = 3
ALPHA = (2 * DEPTH) ** 0.25
BETA = (8 * DEPTH) ** -0.25
LN_EPS = 1e-5

kernel_name = 'fox_rglru_gmlp_convffn_stream_step'


def layer_norm(x, g, b):
    xf = x.astype(jnp.float32)
    mu = jnp.mean(xf, axis=-1, keepdims=True)
    var = jnp.mean(jnp.square(xf - mu), axis=-1, keepdims=True)
    return ((xf - mu) * lax.rsqrt(var + LN_EPS) * g + b).astype(x.dtype)


def causal_dwconv(x, state, w, b):
    width = w.shape[0]
    t = x.shape[1]
    xp = jnp.concatenate([state.astype(x.dtype), x], axis=1)
    y = b
    for j in range(width):
        y = y + w[j] * xp[:, j:j + t]
    return y, xp[:, -(width - 1):]


def fox_attend(q, k, v, cq, ck, q_pos, k_pos):
    s = jnp.einsum('bqhd,bkhd->bhqk', q, k).astype(jnp.float32) * (A_HEAD_DIM ** -0.5)
    s = s + (jnp.transpose(cq, (0, 2, 1))[..., :, None] - jnp.transpose(ck, (0, 2, 1))[..., None, :])
    mask = k_pos[None, :] <= q_pos[:, None]
    s = jnp.where(mask, s, -jnp.inf)
    p = jax.nn.softmax(s, axis=-1).astype(v.dtype)
    return jnp.einsum('bhqk,bkhd->bqhd', p, v)


def fox_prompt(q, k, v, c):
    bsz, t, h, d = q.shape
    pos = jnp.arange(t)

    def one_block(i):
        start = i * Q_BLOCK
        qb = lax.dynamic_slice_in_dim(q, start, Q_BLOCK, axis=1)
        cb = lax.dynamic_slice_in_dim(c, start, Q_BLOCK, axis=1)
        return fox_attend(qb, k, v, cb, c, start + jnp.arange(Q_BLOCK), pos)

    out = lax.map(one_block, jnp.arange(t // Q_BLOCK))
    return jnp.transpose(out, (1, 0, 2, 3, 4)).reshape(bsz, t, h, d)


def rg_lru(xb, conv_state, h0, conv_w, conv_b, wa, ba, wx, bx, lam):
    xc, conv_new = causal_dwconv(xb, conv_state, conv_w, conv_b)
    bsz, t, _ = xc.shape
    xg = xc.reshape(bsz, t, B_BLOCKS, B_BLOCK_DIM)
    gate_r = jax.nn.sigmoid(jnp.einsum('btnc,ncd->btnd', xg, wa).reshape(bsz, t, B_WIDTH) + ba)
    gate_i = jax.nn.sigmoid(jnp.einsum('btnc,ncd->btnd', xg, wx).reshape(bsz, t, B_WIDTH) + bx)
    log_a = -RG_C * gate_r.astype(jnp.float32) * jax.nn.softplus(-lam.astype(jnp.float32))
    a = jnp.exp(log_a)
    u = jnp.sqrt(-jnp.expm1(2.0 * log_a)) * (gate_i * xc).astype(jnp.float32)
    u = u.at[:, 0].add(a[:, 0] * h0.astype(jnp.float32))

    def combine(left, right):
        a1, b1 = left
        a2, b2 = right
        return a1 * a2, a2 * b1 + b2

    _, h = lax.associative_scan(combine, (a, u), axis=1)
    return h.astype(xb.dtype), conv_new, h[:, -1].astype(xb.dtype)


def even_mixer(x, past, w_in, b_f, rg_conv_w, rg_conv_b, rg_wa, rg_ba, rg_wx, rg_bx, rg_lam, w_out):
    bsz, t, _ = x.shape
    q, k, v, f, xb, gb = jnp.split(x @ w_in, list(E_SPLITS), axis=-1)
    q = q.reshape(bsz, t, A_HEADS, A_HEAD_DIM)
    k = k.reshape(bsz, t, A_HEADS, A_HEAD_DIM)
    v = v.reshape(bsz, t, A_HEADS, A_HEAD_DIM)
    logf = jax.nn.log_sigmoid((f + b_f).astype(jnp.float32))
    cum = jnp.cumsum(logf, axis=1)
    if past is None:
        attn = fox_prompt(q, k, v, cum)
        conv_s = jnp.zeros((bsz, RG_CONV - 1, B_WIDTH), x.dtype)
        h0 = jnp.zeros((bsz, B_WIDTH), jnp.float32)
    else:
        k_c, v_c, lf_c, conv_s, h0 = past
        plen = k_c.shape[1]
        lf_c = lf_c.astype(jnp.float32)
        rev = jnp.flip(jnp.cumsum(jnp.flip(lf_c, 1), axis=1), 1)
        ck = jnp.concatenate([lf_c - rev, cum], axis=1)
        k_all = jnp.concatenate([k_c.astype(k.dtype), k], axis=1)
        v_all = jnp.concatenate([v_c.astype(v.dtype), v], axis=1)
        attn = fox_attend(q, k_all, v_all, cum, ck, plen + jnp.arange(t), jnp.arange(plen + t))
    h, conv_new, h_last = rg_lru(xb, conv_s, h0, rg_conv_w, rg_conv_b, rg_wa, rg_ba, rg_wx, rg_bx, rg_lam)
    y = jnp.concatenate([attn.reshape(bsz, t, A_WIDTH), jax.nn.gelu(gb) * h], axis=-1) @ w_out
    return y, (k, v, logf, conv_new, h_last)


def odd_mixer(x, w_in, sgu_g, sgu_b, sgu_w, sgu_bias, w_out):
    bsz, t, _ = x.shape
    z = jax.nn.gelu(x @ w_in)
    u, v = jnp.split(z, 2, axis=-1)
    v = layer_norm(v, sgu_g, sgu_b)
    length = min(t, C_LEN)
    nc = t // length
    vg = v.reshape(bsz, nc, length, C_GROUPS, C_GROUP_DIM)
    ws = sgu_w[:, :length, :length] * jnp.tril(jnp.ones((length, length), sgu_w.dtype))
    mixed = jnp.einsum('gts,bnsgc->bntgc', ws, vg) + sgu_bias[:, :length].T[None, None, :, :, None]
    y = (u * mixed.reshape(bsz, t, C_WIDTH)) @ w_out
    return y, v


def conv_ffn(x, conv_state, w_up, conv_w, conv_b, w_down):
    hc, new_state = causal_dwconv(x @ w_up, conv_state, conv_w, conv_b)
    g, u = jnp.split(hc, 2, axis=-1)
    return (jax.nn.gelu(g) * u) @ w_down, new_state


def setup_inputs(seed: int = 0) -> dict:
    key = jax.random.key(seed)
    ks = jax.random.split(key, 40)
    nrm = lambda i, shape: jax.random.normal(ks[i], shape, jnp.float32)
    w_in_e = nrm(10, (N_EVEN, D_MODEL, E_COLS)) * D_MODEL ** -0.5
    w_in_e = w_in_e.at[..., 2 * A_WIDTH:3 * A_WIDTH].multiply(BETA)
    u_a = jax.random.uniform(ks[18], (N_EVEN, B_WIDTH), jnp.float32, minval=0.9, maxval=0.999)
    a_base = u_a ** (1.0 / RG_C)
    return {
        'x_prompt': nrm(0, (BATCH, SEQ, D_MODEL)),
        'x_sample': nrm(1, (DEC_BATCH, DEC_SEQ, D_MODEL)),
        'cache_k': nrm(2, (N_EVEN, DEC_BATCH, PAST_LEN, A_HEADS, A_HEAD_DIM)),
        'cache_v': nrm(3, (N_EVEN, DEC_BATCH, PAST_LEN, A_HEADS, A_HEAD_DIM)) * BETA,
        'cache_logf': jax.nn.log_sigmoid(2.0 + nrm(4, (N_EVEN, DEC_BATCH, PAST_LEN, A_HEADS))),
        'state_rglru_conv': nrm(5, (N_EVEN, DEC_BATCH, RG_CONV - 1, B_WIDTH)),
        'state_rglru_h': nrm(6, (N_EVEN, DEC_BATCH, B_WIDTH)) * 0.5,
        'state_ffn_conv': nrm(7, (DEPTH, DEC_BATCH, FFN_CONV - 1, 2 * D_FF)),
        'w_in_e': w_in_e,
        'b_f': 2.0 + 0.1 * nrm(11, (N_EVEN, A_HEADS)),
        'rg_conv_w': nrm(12, (N_EVEN, RG_CONV, B_WIDTH)) * RG_CONV ** -0.5,
        'rg_conv_b': 0.01 * nrm(13, (N_EVEN, B_WIDTH)),
        'rg_wa': nrm(14, (N_EVEN, B_BLOCKS, B_BLOCK_DIM, B_BLOCK_DIM)) * B_BLOCK_DIM ** -0.5,
        'rg_ba': 0.01 * nrm(15, (N_EVEN, B_WIDTH)),
        'rg_wx': nrm(16, (N_EVEN, B_BLOCKS, B_BLOCK_DIM, B_BLOCK_DIM)) * B_BLOCK_DIM ** -0.5,
        'rg_bx': 0.01 * nrm(17, (N_EVEN, B_WIDTH)),
        'rg_lam': jnp.log(a_base) - jnp.log1p(-a_base),
        'w_out_e': nrm(19, (N_EVEN, A_WIDTH + B_WIDTH, D_MODEL)) * (A_WIDTH + B_WIDTH) ** -0.5 * BETA,
        'w_in_o': nrm(20, (N_ODD, D_MODEL, 2 * C_WIDTH)) * D_MODEL ** -0.5,
        'sgu_g': 1.0 + 0.1 * nrm(21, (N_ODD, C_WIDTH)),
        'sgu_b': 0.01 * nrm(22, (N_ODD, C_WIDTH)),
        'sgu_w': nrm(23, (N_ODD, C_GROUPS, C_LEN, C_LEN)) * C_LEN ** -0.5,
        'sgu_bias': 1.0 + 0.1 * nrm(24, (N_ODD, C_GROUPS, C_LEN)),
        'w_out_o': nrm(25, (N_ODD, C_WIDTH, D_MODEL)) * C_WIDTH ** -0.5 * BETA,
        'ln_mix_g': 1.0 + 0.1 * nrm(26, (DEPTH, D_MODEL)),
        'ln_mix_b': 0.01 * nrm(27, (DEPTH, D_MODEL)),
        'ln_ffn_g': 1.0 + 0.1 * nrm(28, (DEPTH, D_MODEL)),
        'ln_ffn_b': 0.01 * nrm(29, (DEPTH, D_MODEL)),
        'ffn_w_up': nrm(30, (DEPTH, D_MODEL, 2 * D_FF)) * D_MODEL ** -0.5,
        'ffn_conv_w': nrm(31, (DEPTH, FFN_CONV, 2 * D_FF)) * FFN_CONV ** -0.5,
        'ffn_conv_b': 0.01 * nrm(32, (DEPTH, 2 * D_FF)),
        'ffn_w_down': nrm(33, (DEPTH, D_FF, D_MODEL)) * D_FF ** -0.5 * BETA,
    }


def reference(x_prompt, x_sample, cache_k, cache_v, cache_logf, state_rglru_conv, state_rglru_h,
              state_ffn_conv, w_in_e, b_f, rg_conv_w, rg_conv_b, rg_wa, rg_ba, rg_wx, rg_bx, rg_lam,
              w_out_e, w_in_o, sgu_g, sgu_b, sgu_w, sgu_bias, w_out_o, ln_mix_g, ln_mix_b,
              ln_ffn_g, ln_ffn_b, ffn_w_up, ffn_conv_w, ffn_conv_b, ffn_w_down):
    xp, xs = x_prompt, x_sample
    kp_l, vp_l, lfp_l, rcp_l, rhp_l = [], [], [], [], []
    ks_l, vs_l, lfs_l, rcs_l, rhs_l = [], [], [], [], []
    fcp_l, fcs_l, sgv_l = [], [], []
    for layer in range(DEPTH):
        if layer % 2 == 0:
            e = layer // 2
            prm = (w_in_e[e], b_f[e], rg_conv_w[e], rg_conv_b[e], rg_wa[e], rg_ba[e],
                   rg_wx[e], rg_bx[e], rg_lam[e], w_out_e[e])
            mp, (kp, vp, lfp, rcp, rhp) = even_mixer(xp, None, *prm)
            past = (cache_k[e], cache_v[e], cache_logf[e], state_rglru_conv[e], state_rglru_h[e])
            ms, (ks_, vs_, lfs, rcs, rhs) = even_mixer(xs, past, *prm)
            kp_l.append(kp); vp_l.append(vp); lfp_l.append(lfp); rcp_l.append(rcp); rhp_l.append(rhp)
            ks_l.append(ks_); vs_l.append(vs_); lfs_l.append(lfs); rcs_l.append(rcs); rhs_l.append(rhs)
        else:
            o = layer // 2
            prm = (w_in_o[o], sgu_g[o], sgu_b[o], sgu_w[o], sgu_bias[o], w_out_o[o])
            mp, _ = odd_mixer(xp, *prm)
            ms, sv = odd_mixer(xs, *prm)
            sgv_l.append(sv)
        xp = layer_norm(ALPHA * xp + mp, ln_mix_g[layer], ln_mix_b[layer])
        xs = layer_norm(ALPHA * xs + ms, ln_mix_g[layer], ln_mix_b[layer])
        fprm = (ffn_w_up[layer], ffn_conv_w[layer], ffn_conv_b[layer], ffn_w_down[layer])
        zero_fc = jnp.zeros((xp.shape[0], FFN_CONV - 1, 2 * D_FF), xp.dtype)
        fp, fcp = conv_ffn(xp, zero_fc, *fprm)
        fs, fcs = conv_ffn(xs, state_ffn_conv[layer], *fprm)
        fcp_l.append(fcp); fcs_l.append(fcs)
        xp = layer_norm(ALPHA * xp + fp, ln_ffn_g[layer], ln_ffn_b[layer])
        xs = layer_norm(ALPHA * xs + fs, ln_ffn_g[layer], ln_ffn_b[layer])
    return (xp, xs,
            jnp.stack(kp_l), jnp.stack(vp_l), jnp.stack(lfp_l),
            jnp.stack(ks_l), jnp.stack(vs_l), jnp.stack(lfs_l),
            jnp.stack(rcp_l), jnp.stack(rhp_l), jnp.stack(rcs_l), jnp.stack(rhs_l),
            jnp.stack(fcp_l), jnp.stack(fcs_l), jnp.stack(sgv_l))
```

```cpp
#include <hip/hip_runtime.h>
#include <cstdio>
#include <cstdint>
#include <cmath>
#define MK_N_LAUNCHES 19
namespace pg8 {
#define PG8_LAS __attribute__((address_space(3)))
typedef unsigned short bf16_t;
typedef short bf16x8 __attribute__((ext_vector_type(8)));
typedef float f32x4 __attribute__((ext_vector_type(4)));
typedef unsigned u32x4 __attribute__((ext_vector_type(4)));
constexpr int BM = 256, BK = 64, HALF = 128, HTB = HALF * BK * 2  , STAGE_BYTES = 8 * HTB, NXCD = 8, WGM = 8;

__host__ __device__ __forceinline__ int lds_byte(int r, int c) { const int st = (r >> 4) * 2 + (c >> 5), rr = r & 15, cc = c & 31, ob = rr * 64 + cc * 2; return st * 1024 + (ob ^ (((ob >> 9) & 1) << 5)); }
__host__ __device__ __forceinline__ void stage_rc(int b, int& R, int& C) { const int st = b / 1024, sb = b % 1024, swz = sb ^ (((sb >> 9) & 1) << 5); R = (st >> 1) * 16 + swz / 64; C = (st & 1) * 32 + (swz % 64) / 2; }
__host__ __device__ __forceinline__ int perm32(int rho) { const int n = rho >> 4, i = rho & 15; return 8 * (i >> 2) + 4 * n + (i & 3); }

struct Unit { int pm, pn; };
struct Gemm { const bf16_t* A; const bf16_t* Bt; int M, N, K; };

struct StaticOrder {
    int nM, nN, nwg, G, c;
    __host__ __device__ void init(int M, int N, int G_, int c_) { nM = M / BM; nN = N / BM; nwg = nM * nN; G = G_; c = c_; }
    __host__ __device__ bool next(int i, Unit& u) const {
        const long L = (long)i * G + c; if (L >= nwg) return false;
        int wgid = (int)L; { const int q = nwg / NXCD, r = nwg % NXCD, xcd = wgid % NXCD, off = wgid / NXCD; wgid = (xcd < r ? xcd * (q + 1) : r * (q + 1) + (xcd - r) * q) + off; }
        const int nig = WGM * nN, gid = wgid / nig, fm = gid * WGM, gsz = (nM - fm) < WGM ? (nM - fm) : WGM;
        u.pm = fm + ((wgid % nig) % gsz); u.pn = (wgid % nig) / gsz; return true;
    }
    __device__ __forceinline__ void a_ready(const Unit&) const {}
    __device__ __forceinline__ void done(const Unit&) const {}
};
__device__ __forceinline__ unsigned cvt_pk_bf16(float lo, float hi) { unsigned r; asm volatile("v_cvt_pk_bf16_f32 %0, %1, %2" : "=v"(r) : "v"(lo), "v"(hi)); return r; }
typedef float f32x2 __attribute__((ext_vector_type(2)));
__device__ __forceinline__ float gelu_tanh(float x) {
    const float y = x * (1.0f + 0.044715f * x * x);
    const float e = __builtin_amdgcn_exp2f(-2.302208198f * y);
    return x * __builtin_amdgcn_rcpf(1.0f + e);
}
__device__ __forceinline__ void st_bf16x8(bf16_t* p, f32x4 v0, f32x4 v1) {
    u32x4 w; w.x = cvt_pk_bf16(v0[0], v0[1]); w.y = cvt_pk_bf16(v0[2], v0[3]); w.z = cvt_pk_bf16(v1[0], v1[1]); w.w = cvt_pk_bf16(v1[2], v1[3]); *(u32x4*)p = w;
}
__device__ __forceinline__ void st_f32x8(float* p, f32x4 v0, f32x4 v1) { *(f32x4*)p = v0; *(f32x4*)(p + 4) = v1; }
__device__ __forceinline__ f32x4 gelu4(f32x4 v) { return (f32x4){gelu_tanh(v[0]), gelu_tanh(v[1]), gelu_tanh(v[2]), gelu_tanh(v[3])}; }

constexpr int E_MP = 16384;

struct EpiInE {
    static constexpr bool PERM = true, AFTER_DRAIN = false;
    bf16_t *Q, *K, *V, *XB, *GB;
    float *okp, *ovp, *oks, *ovs, *orcp, *orcs;
    float qscale;
    __device__ __forceinline__ void operator()(const f32x4 (&acc)[2][2][4][2], const Unit& u, int wr, int wc, int fr, int fq) const {
        const int seg = u.pn >> 1; const int cb0 = (u.pn & 1) * 256 + wc * 32 + 8 * fq; const bool prm = u.pm < 64;
#pragma unroll
        for (int ai = 0; ai < 2; ++ai)
#pragma unroll
            for (int m = 0; m < 4; ++m) { const int row = u.pm * BM + ai * HALF + wr * 64 + m * 16 + fr;
#pragma unroll
                for (int bj = 0; bj < 2; ++bj) { const int c = cb0 + bj * HALF; const f32x4 v0 = acc[ai][bj][m][0], v1 = acc[ai][bj][m][1]; const size_t o = (size_t)row * 512 + c;
                    if (seg == 0) { st_bf16x8(Q + o, v0 * qscale, v1 * qscale); }
                    else if (seg == 1) { st_bf16x8(K + o, v0, v1); st_f32x8(prm ? okp + o : oks + (o - (size_t)E_MP * 512), v0, v1); }
                    else if (seg == 2) { st_bf16x8(V + o, v0, v1); st_f32x8(prm ? ovp + o : ovs + (o - (size_t)E_MP * 512), v0, v1); }
                    else if (seg == 3) { st_bf16x8(XB + o, v0, v1);
                        if (prm) { const int t = row & 4095; if (t >= 4093) st_f32x8(orcp + ((size_t)(row >> 12) * 3 + (t - 4093)) * 512 + c, v0, v1); }
                        else { const int rs = row - E_MP, t = rs & 63; if (t >= 61) st_f32x8(orcs + ((size_t)(rs >> 6) * 3 + (t - 61)) * 512 + c, v0, v1); } }
                    else { st_bf16x8(GB + o, gelu4(v0), gelu4(v1)); } } }
    }
};
struct EpiF32 {
    static constexpr bool PERM = true, AFTER_DRAIN = false;
    float* Y; int ldc;
    __device__ __forceinline__ void operator()(const f32x4 (&acc)[2][2][4][2], const Unit& u, int wr, int wc, int fr, int fq) const {
        const int c0 = u.pn * BM + wc * 32 + 8 * fq;
#pragma unroll
        for (int ai = 0; ai < 2; ++ai)
#pragma unroll
            for (int m = 0; m < 4; ++m) { const int row = u.pm * BM + ai * HALF + wr * 64 + m * 16 + fr;
#pragma unroll
                for (int bj = 0; bj < 2; ++bj) st_f32x8(Y + (size_t)row * ldc + c0 + bj * HALF, acc[ai][bj][m][0], acc[ai][bj][m][1]); }
    }
};
struct EpiUp {
    static constexpr bool PERM = true, AFTER_DRAIN = false;
    bf16_t* H; float *ofcp, *ofcs;
    __device__ __forceinline__ void operator()(const f32x4 (&acc)[2][2][4][2], const Unit& u, int wr, int wc, int fr, int fq) const {
        const int c0 = u.pn * BM + wc * 32 + 8 * fq; const bool prm = u.pm < 64;
#pragma unroll
        for (int ai = 0; ai < 2; ++ai)
#pragma unroll
            for (int m = 0; m < 4; ++m) { const int row = u.pm * BM + ai * HALF + wr * 64 + m * 16 + fr;
#pragma unroll
                for (int bj = 0; bj < 2; ++bj) { const int c = c0 + bj * HALF; const f32x4 v0 = acc[ai][bj][m][0], v1 = acc[ai][bj][m][1];
                    st_bf16x8(H + (size_t)row * 5632 + c, v0, v1);
                    if (prm) { const int t = row & 4095; if (t >= 4094) st_f32x8(ofcp + ((size_t)(row >> 12) * 2 + (t - 4094)) * 5632 + c, v0, v1); }
                    else { const int rs = row - E_MP, t = rs & 63; if (t >= 62) st_f32x8(ofcs + ((size_t)(rs >> 6) * 2 + (t - 62)) * 5632 + c, v0, v1); } } }
    }
};
struct EpiInO {
    static constexpr bool PERM = true, AFTER_DRAIN = false;
    bf16_t* U; float* VR;
    __device__ __forceinline__ void operator()(const f32x4 (&acc)[2][2][4][2], const Unit& u, int wr, int wc, int fr, int fq) const {
        const bool isu = u.pn < 4; const int c0 = (u.pn & 3) * BM + wc * 32 + 8 * fq;
#pragma unroll
        for (int ai = 0; ai < 2; ++ai)
#pragma unroll
            for (int m = 0; m < 4; ++m) { const int row = u.pm * BM + ai * HALF + wr * 64 + m * 16 + fr;
#pragma unroll
                for (int bj = 0; bj < 2; ++bj) { const size_t o = (size_t)row * 1024 + c0 + bj * HALF; const f32x4 v0 = gelu4(acc[ai][bj][m][0]), v1 = gelu4(acc[ai][bj][m][1]);
                    if (isu) st_bf16x8(U + o, v0, v1); else st_f32x8(VR + o, v0, v1); } }
    }
};
template <class Epi, class Sched, bool ALIGN_EPI = false, bool SP2 = false>
__device__ __forceinline__ void gemm_phase(PG8_LAS unsigned char* lds, const Gemm g, const Sched& S, const Epi& E) {
    const int tid = threadIdx.x, wid = __builtin_amdgcn_readfirstlane(tid >> 6), lane = tid & 63, wr = wid >> 2, wc = wid & 3, fr = lane & 15, fq = lane >> 4;
    const int K = g.K, nt = K / BK;
    unsigned voffA[2], voffB[2];
#pragma unroll
    for (int i = 0; i < 2; ++i) { int R, C; stage_rc(tid * 16 + i * 8192, R, C); const int Rb = Epi::PERM ? ((R & ~31) + perm32(R & 31)) : R;
        voffA[i] = (unsigned)(R * K + C) * 2u; voffB[i] = (unsigned)(Rb * K + C) * 2u; }
    const size_t kstep = (size_t)(BK * 2);
    const size_t hstep = (size_t)HALF * K * 2;
    const size_t tstep = 2 * hstep;
    const unsigned ldsw = (unsigned)wid * 1024u;
    const int aoff = lds_byte(wr * 64 + fr, fq * 8), boff = lds_byte(wc * 32 + fr, fq * 8);
#define PG8_SA(b, h) (((b) * 2 + (h)) * HTB)
#define PG8_SB(b, h) ((4 + (b) * 2 + (h)) * HTB)
#define PG8_STAGE(bufoff, gbase, voff) do { _Pragma("unroll") for (int _i = 0; _i < 2; ++_i) \
        __builtin_amdgcn_global_load_lds((const unsigned*)((const char*)(gbase) + (voff)[_i]), (PG8_LAS unsigned*)(lds + (bufoff) + ldsw + _i * 8192), 16, 0, 0); } while (0)
#define PG8_LDA(dst, b, h) do { _Pragma("unroll") for (int m = 0; m < 4; ++m) _Pragma("unroll") for (int k = 0; k < 2; ++k) dst[m][k] = *(const PG8_LAS bf16x8*)(lds + PG8_SA(b, h) + aoff + m * 2048 + k * 1024); } while (0)
#define PG8_LDB(dst, b, h) do { _Pragma("unroll") for (int n = 0; n < 2; ++n) _Pragma("unroll") for (int k = 0; k < 2; ++k) dst[n][k] = *(const PG8_LAS bf16x8*)(lds + PG8_SB(b, h) + boff + n * 2048 + k * 1024); } while (0)
#define PG8_MMA(ai, bj, At, Bt) do { __builtin_amdgcn_s_setprio(1); _Pragma("unroll") for (int m = 0; m < 4; ++m) _Pragma("unroll") for (int n = 0; n < 2; ++n) _Pragma("unroll") for (int k = 0; k < 2; ++k) \
        acc[ai][bj][m][n] = __builtin_amdgcn_mfma_f32_16x16x32_bf16(Bt[n][k], At[m][k], acc[ai][bj][m][n], 0, 0, 0); __builtin_amdgcn_s_setprio(0); } while (0)
#define PG8_WAIT_V(n) asm volatile("s_waitcnt vmcnt(" #n ")" ::: "memory")
#define PG8_WAIT_L(n) asm volatile("s_waitcnt lgkmcnt(" #n ")" ::: "memory")
#define PG8_BAR __builtin_amdgcn_s_barrier()
#define PG8_SCHED __builtin_amdgcn_sched_barrier(0)
    Unit cur, nxt; int ui = 0;
    if (!S.next(0, cur)) return;
    f32x4 acc[2][2][4][2];
#pragma unroll
    for (int a = 0; a < 2; ++a)
#pragma unroll
        for (int b = 0; b < 2; ++b)
#pragma unroll
            for (int m = 0; m < 4; ++m)
#pragma unroll
                for (int n = 0; n < 2; ++n) acc[a][b][m][n] = (f32x4){0.f, 0.f, 0.f, 0.f};
    bf16x8 At[4][2], B0[2][2], B1[2][2];
    const char* cA = (const char*)g.A + (size_t)cur.pm * tstep; const char* cB = (const char*)g.Bt + (size_t)cur.pn * tstep;
    S.a_ready(cur);
    if constexpr (SP2) {
        PG8_STAGE(PG8_SB(0, 0), cB, voffB); PG8_STAGE(PG8_SB(0, 1), cB + hstep, voffB); PG8_STAGE(PG8_SA(0, 0), cA, voffA); PG8_STAGE(PG8_SA(0, 1), cA + hstep, voffA);
        if (wr == 1) PG8_BAR;
        PG8_WAIT_V(2); PG8_BAR;
        PG8_STAGE(PG8_SB(1, 0), cB + kstep, voffB); PG8_STAGE(PG8_SA(1, 0), cA + kstep, voffA); PG8_STAGE(PG8_SB(1, 1), cB + hstep + kstep, voffB);
        PG8_WAIT_V(6); PG8_BAR;
    } else {
        PG8_STAGE(PG8_SB(0, 0), cB, voffB); PG8_STAGE(PG8_SA(0, 0), cA, voffA); PG8_STAGE(PG8_SB(0, 1), cB + hstep, voffB); PG8_STAGE(PG8_SA(0, 1), cA + hstep, voffA);
        if (wr == 1) PG8_BAR;
        PG8_WAIT_V(4); PG8_BAR;
        PG8_STAGE(PG8_SB(1, 0), cB + kstep, voffB); PG8_STAGE(PG8_SA(1, 0), cA + kstep, voffA); PG8_STAGE(PG8_SB(1, 1), cB + hstep + kstep, voffB);
        PG8_WAIT_V(6); PG8_BAR;
    }
    for (;;) {
        const bool has_next = S.next(ui + 1, nxt);
        const char* nA = has_next ? (const char*)g.A + (size_t)nxt.pm * tstep : cA; const char* nB = has_next ? (const char*)g.Bt + (size_t)nxt.pn * tstep : cB;
        for (int t = 0; t < nt; t += 2) {
            const bool last = (t == nt - 2);
            const char* a1 = cA + (size_t)(t + 1) * kstep;
            const char* a2 = last ? nA : cA + (size_t)(t + 2) * kstep; const char* b2 = last ? nB : cB + (size_t)(t + 2) * kstep;
            const char* a3 = a2 + kstep; const char* b3 = b2 + kstep;
            if (last && has_next) S.a_ready(nxt);
            if constexpr (SP2) {
            PG8_LDB(B0, 0, 0); PG8_LDB(B1, 0, 1); PG8_SCHED; PG8_LDA(At, 0, 0); PG8_STAGE(PG8_SA(1, 1), a1 + hstep, voffA);
            PG8_WAIT_V(8); PG8_WAIT_L(0); PG8_BAR; PG8_MMA(0, 0, At, B0); PG8_MMA(0, 1, At, B1); PG8_BAR; PG8_SCHED;
            PG8_LDA(At, 0, 1); PG8_STAGE(PG8_SB(0, 0), b2, voffB); PG8_STAGE(PG8_SB(0, 1), b2 + hstep, voffB); PG8_STAGE(PG8_SA(0, 0), a2, voffA);
            PG8_WAIT_V(8); PG8_WAIT_L(0); PG8_BAR; PG8_MMA(1, 0, At, B0); PG8_MMA(1, 1, At, B1); PG8_BAR; PG8_SCHED;
            PG8_LDB(B0, 1, 0); PG8_LDB(B1, 1, 1); PG8_SCHED; PG8_LDA(At, 1, 0); PG8_STAGE(PG8_SA(0, 1), a2 + hstep, voffA);
            PG8_WAIT_V(8); PG8_WAIT_L(0); PG8_BAR; PG8_MMA(0, 0, At, B0); PG8_MMA(0, 1, At, B1); PG8_BAR; PG8_SCHED;
            PG8_LDA(At, 1, 1); PG8_STAGE(PG8_SB(1, 0), b3, voffB); PG8_STAGE(PG8_SB(1, 1), b3 + hstep, voffB); PG8_STAGE(PG8_SA(1, 0), a3, voffA);
            PG8_WAIT_V(8); PG8_WAIT_L(0); PG8_BAR; PG8_MMA(1, 0, At, B0); PG8_MMA(1, 1, At, B1); PG8_BAR; PG8_SCHED;
            } else {
            PG8_LDB(B0, 0, 0); PG8_SCHED; PG8_LDA(At, 0, 0); PG8_STAGE(PG8_SA(1, 1), a1 + hstep, voffA);
            PG8_WAIT_L(8); PG8_BAR; PG8_WAIT_L(0); PG8_MMA(0, 0, At, B0); PG8_BAR; PG8_SCHED;
            PG8_LDB(B1, 0, 1); PG8_STAGE(PG8_SB(0, 0), b2, voffB);
            PG8_BAR; PG8_WAIT_L(0); PG8_MMA(0, 1, At, B1); PG8_BAR;
            PG8_LDA(At, 0, 1); PG8_STAGE(PG8_SA(0, 0), a2, voffA);
            PG8_BAR; PG8_WAIT_L(0); PG8_MMA(1, 0, At, B0); PG8_BAR; PG8_SCHED;
            PG8_STAGE(PG8_SB(0, 1), b2 + hstep, voffB);
            PG8_WAIT_V(6); PG8_BAR; PG8_MMA(1, 1, At, B1); PG8_BAR;
            PG8_LDB(B0, 1, 0); PG8_SCHED; PG8_LDA(At, 1, 0); PG8_STAGE(PG8_SA(0, 1), a2 + hstep, voffA);
            PG8_WAIT_L(8); PG8_BAR; PG8_WAIT_L(0); PG8_MMA(0, 0, At, B0); PG8_BAR; PG8_SCHED;
            PG8_LDB(B1, 1, 1); PG8_STAGE(PG8_SB(1, 0), b3, voffB);
            PG8_BAR; PG8_WAIT_L(0); PG8_MMA(0, 1, At, B1); PG8_BAR;
            PG8_LDA(At, 1, 1); PG8_STAGE(PG8_SA(1, 0), a3, voffA);
            PG8_BAR; PG8_WAIT_L(0); PG8_MMA(1, 0, At, B0); PG8_BAR; PG8_SCHED;
            PG8_STAGE(PG8_SB(1, 1), b3 + hstep, voffB);
            PG8_WAIT_V(6); PG8_BAR; PG8_MMA(1, 1, At, B1); PG8_BAR;
            }
        }
        if constexpr (ALIGN_EPI) { if (wr == 0) PG8_BAR; }
        if constexpr (!Epi::AFTER_DRAIN) { E(acc, cur, wr, wc, fr, fq); S.done(cur); }
        if (!has_next) break;
#pragma unroll
        for (int a = 0; a < 2; ++a)
#pragma unroll
            for (int b = 0; b < 2; ++b)
#pragma unroll
                for (int m = 0; m < 4; ++m)
#pragma unroll
                    for (int n = 0; n < 2; ++n) acc[a][b][m][n] = (f32x4){0.f, 0.f, 0.f, 0.f};
        cur = nxt; cA = nA; cB = nB; ++ui;
        if constexpr (ALIGN_EPI) { if (wr == 1) PG8_BAR; }
    }
    PG8_WAIT_V(0);
    if constexpr (!ALIGN_EPI) { if (wr == 0) PG8_BAR; }
    PG8_BAR;
    if constexpr (Epi::AFTER_DRAIN) { E.fused(acc, cur, wr, wc, fr, fq, lds, wid, lane); S.done(cur); }
#undef PG8_SA
#undef PG8_SB
#undef PG8_STAGE
#undef PG8_LDA
#undef PG8_LDB
#undef PG8_MMA
#undef PG8_WAIT_V
#undef PG8_WAIT_L
#undef PG8_BAR
#undef PG8_SCHED
}
}
#define GAS __attribute__((address_space(1)))
#define LAS __attribute__((address_space(3)))
typedef unsigned short bf16;
typedef unsigned v4u __attribute__((ext_vector_type(4)));
typedef float f32x4 __attribute__((ext_vector_type(4)));
typedef short bf16x8 __attribute__((ext_vector_type(8)));
typedef GAS unsigned gu32;
typedef GAS unsigned long long gu64;
#define RLX_AGENT __ATOMIC_RELAXED, __HIP_MEMORY_SCOPE_AGENT
#define LDS_WAIT() asm volatile("s_waitcnt lgkmcnt(0)" ::: "memory")
#define VM_WAIT() asm volatile("s_waitcnt vmcnt(0)" ::: "memory")
__device__ __forceinline__ unsigned long long rt() { return __builtin_amdgcn_s_memrealtime(); }
__device__ __forceinline__ unsigned f2bf(float f) { unsigned u = __builtin_bit_cast(unsigned, f); return (u + 0x7fffu + ((u >> 16) & 1u)) >> 16; }
__device__ __forceinline__ unsigned pk2(float lo, float hi) { return f2bf(lo) | (f2bf(hi) << 16); }

#define XB_TMO      128
#define XB_XCNT(j)  (256  + 64 * (j))
#define XB_XSUB(j)  (1280 + 64 * (j))
#define XB_XGEN(j)  (2304 + 64 * (j))
#define XB_TOP      3328
#define XB_TOPGEN   3392
#define XCD_BAR_WORDS 3456
#define XB_SPIN_CAP (1u << 18)

__device__ __forceinline__ unsigned xb_ld(unsigned* p)              { return __hip_atomic_load(p, __ATOMIC_RELAXED, __HIP_MEMORY_SCOPE_AGENT); }
__device__ __forceinline__ unsigned xb_add(unsigned* p, unsigned v) { return __hip_atomic_fetch_add(p, v, __ATOMIC_RELAXED, __HIP_MEMORY_SCOPE_AGENT); }
__device__ __forceinline__ unsigned xb_xcc_id() { return (unsigned)__builtin_amdgcn_s_getreg((3 << 11) | 20) & 0xFu; }
#define XB_SPIN(cond, bar) do { unsigned _sp = 0; while (cond) { __builtin_amdgcn_s_sleep(1); \
    if ((++_sp & 255u) == 0u) { if (xb_ld(&(bar)[XB_TMO])) break; if (_sp > XB_SPIN_CAP) { atomicAdd(&(bar)[XB_TMO], 1u); break; } } } } while (0)

struct XcdBarrier {
    unsigned* bar; unsigned x;
    volatile LAS unsigned* st;
};

__device__ __forceinline__ XcdBarrier xcd_barrier_post(unsigned* bar, volatile LAS unsigned* st) {
    XcdBarrier b; b.bar = bar; b.x = xb_xcc_id(); b.st = st;
    if (threadIdx.x == 0) (void)xb_add(&bar[XB_XCNT(b.x)], 1u);
    return b;
}
__device__ __forceinline__ void xcd_barrier_complete(unsigned* bar, unsigned x, unsigned& nloc, unsigned& nx) {
    const unsigned G = gridDim.x * gridDim.y * gridDim.z;
    unsigned sum, cnt, mine, sp = 0u;
    for (;;) {
        sum = 0u; cnt = 0u; mine = 0u;
#pragma unroll
        for (unsigned j = 0; j < 16; ++j) { const unsigned c = xb_ld(&bar[XB_XCNT(j)]); sum += c; cnt += (c > 0u) ? 1u : 0u; mine = (j == x) ? c : mine; }
        if (sum == G) break;
        __builtin_amdgcn_s_sleep(1);
        if ((++sp & 255u) == 0u) { if (xb_ld(&bar[XB_TMO])) break; if (sp > XB_SPIN_CAP) { atomicAdd(&bar[XB_TMO], 1u); break; } }
    }
    nloc = mine > 0u ? mine : 1u; nx = cnt > 0u ? cnt : 1u;
}

__device__ __forceinline__ void xcd_barrier(const XcdBarrier& b) {
    asm volatile("s_waitcnt vmcnt(0)" ::: "memory");
    __syncthreads();
    if (threadIdx.x == 0) {
        unsigned* bar = b.bar;
        __builtin_amdgcn_s_waitcnt(0);
        unsigned nloc = b.st[0], nx = b.st[1];
        if (nloc == 0u) { xcd_barrier_complete(bar, b.x, nloc, nx); b.st[0] = nloc; b.st[1] = nx; }
        const unsigned old = xb_add(&bar[XB_XSUB(b.x)], 1u);
        const unsigned gen = old / nloc;
        if (old + 1u == (gen + 1u) * nloc) {
            __builtin_amdgcn_fence(__ATOMIC_RELEASE, "agent");
            asm volatile("s_waitcnt vmcnt(0)" ::: "memory");
            const unsigned og = xb_add(&bar[XB_TOP], 1u);
            const unsigned tg = og / nx;
            if (og + 1u == (tg + 1u) * nx) xb_add(&bar[XB_TOPGEN], 1u);
            else XB_SPIN(xb_ld(&bar[XB_TOPGEN]) == tg, bar);
            __builtin_amdgcn_fence(__ATOMIC_ACQUIRE, "agent");
            xb_add(&bar[XB_XGEN(b.x)], 1u);
            asm volatile("s_waitcnt vmcnt(0)" ::: "memory");
        } else {
            XB_SPIN(xb_ld(&bar[XB_XGEN(b.x)]) == gen, bar);
            __builtin_amdgcn_fence(__ATOMIC_ACQUIRE, "agent");
            asm volatile("s_waitcnt vmcnt(0)" ::: "memory");
        }
    }
    __syncthreads();
}
constexpr int NWAVES = 8;
constexpr int D = 1024, TP = 4096, TS = 64, NBP = 4, NBS = 32, PAST = 2048;
constexpr int MP = NBP * TP, MS = NBS * TS, M = MP + MS;
constexpr int NH = 8, HDIM = 64, AW = 512, BW = 512, ECOLS = 2568, NE = 2560, FF = 2816, FF2 = 5632;
constexpr float ALPHA = 1.41421356237309505f, LN_EPS = 1e-5f, LOG2E = 1.4426950408889634f, QSCALE = 0.125f * 1.4426950408889634f;
static_assert(MP == pg8::E_MP, "prompt rows");
enum { I_XP = 0, I_XS, I_CK, I_CV, I_CLF, I_SRC, I_SRH, I_SFC, I_WINE, I_BF, I_RCW, I_RCB, I_RWA, I_RBA, I_RWX, I_RBX, I_RLAM, I_WOUTE, I_WINO, I_SGG, I_SGB, I_SGW, I_SGBIAS, I_WOUTO,
       I_LMG, I_LMB, I_LFG, I_LFB, I_WUP, I_FCW, I_FCB, I_WDN, N_IN };
constexpr size_t O_YP = 0, O_YS = O_YP + (size_t)MP * D, O_KP = O_YS + (size_t)MS * D, O_VP = O_KP + (size_t)MP * AW, O_LFP = O_VP + (size_t)MP * AW, O_KS = O_LFP + (size_t)MP * NH,
                 O_VS = O_KS + (size_t)MS * AW, O_LFS = O_VS + (size_t)MS * AW, O_RCP = O_LFS + (size_t)MS * NH, O_RHP = O_RCP + (size_t)NBP * 3 * BW, O_RCS = O_RHP + (size_t)NBP * BW,
                 O_RHS = O_RCS + (size_t)NBS * 3 * BW, O_FCP = O_RHS + (size_t)NBS * BW, O_FCS = O_FCP + (size_t)2 * NBP * 2 * FF2, O_SGV = O_FCS + (size_t)2 * NBS * 2 * FF2, O_END = O_SGV + (size_t)MS * D;
static_assert(O_END == 40878080, "output size");
constexpr size_t MiB = 1u << 20;
constexpr size_t WS_CTL = 0, CTL_ZERO_BYTES = 1 * MiB;
constexpr size_t WS_WINE = 2 * MiB, WS_WOUTE = 7 * MiB, WS_WINO = 9 * MiB, WS_WOUTO = 13 * MiB, WS_WUP0 = 15 * MiB, WS_WUP1 = 26 * MiB, WS_WDN0 = 37 * MiB, WS_WDN1 = WS_WDN0 + 5 * MiB + MiB / 2;
constexpr size_t WS_KBP = 48 * MiB, WS_KBS = WS_KBP + MiB / 2, WS_CARRY = 50 * MiB + 3 * (MiB / 4);
constexpr size_t WS_XA = 52 * MiB;
constexpr size_t WS_XR = 88 * MiB;
constexpr size_t WS_A = 160 * MiB;
constexpr size_t WS_Q = WS_A, WS_K = WS_A + 18 * MiB, WS_V = WS_A + 36 * MiB, WS_XB = WS_A + 54 * MiB, WS_GB = WS_A + 72 * MiB, WS_MIX = WS_A + 90 * MiB, WS_Y = WS_A + 126 * MiB;
constexpr size_t WS_H = WS_A;
constexpr size_t WS_U = WS_A, WS_VN = WS_A + 36 * MiB, WS_G = WS_A + 72 * MiB, WS_VR = WS_Y;
constexpr size_t WS_KC = WS_Y;
constexpr size_t WS_ACT = 358 * MiB, WS_VC = WS_ACT;
constexpr size_t WS_END = 457 * MiB;
static_assert(WS_WDN1 + (size_t)D * FF * 2 <= WS_KBP && WS_KBS + (size_t)256 * 2112 * 4 <= WS_CARRY && WS_CARRY + (size_t)2304 * 64 * 8 <= WS_XA && WS_XA + (size_t)M * D * 2 == WS_XR && WS_XR + (size_t)M * D * 4 == WS_A, "ws map 1");
static_assert(WS_Y + (size_t)M * D * 4 == WS_ACT && WS_H + (size_t)M * FF2 * 2 == WS_ACT && WS_ACT + (size_t)M * FF * 2 == WS_END && WS_MIX + (size_t)M * D * 2 == WS_Y && WS_KC + (size_t)NBS * PAST * AW * 2 <= WS_ACT, "ws map 2");
constexpr int CW_TMO = 0, CW_CODE = 1, CW_BAR = 4096;
constexpr int RING_OFF = 0, RING_BYTES = 131072, LDSCTL_OFF = RING_BYTES, MISC_OFF = LDSCTL_OFF + 320, LDS_BYTES = 147456;
struct Frame {
    LAS unsigned char* lds;
    volatile LAS unsigned* MISC;
    gu32* ctl;
    int tid, lane, wave;
    int vcu, G;
    float* out; unsigned char* ws;
};
typedef const float* cfptr_t;
__device__ __forceinline__ const float* inp_ptr(int i) { return ((const __attribute__((address_space(4))) cfptr_t*)__builtin_amdgcn_kernarg_segment_ptr())[i]; }
#define INP(i) inp_ptr(i)
__device__ __forceinline__ float bf2f(bf16 h) { return __builtin_bit_cast(float, (unsigned)h << 16); }
__device__ __forceinline__ float wave_sum(float v) {
#pragma unroll
    for (int o = 1; o < 64; o <<= 1) v += __shfl_xor(v, o);
    return v;
}
__device__ __forceinline__ void unpack8(v4u w, float (&v)[8]) {
    v[0] = __builtin_bit_cast(float, w.x << 16); v[1] = __builtin_bit_cast(float, w.x & 0xffff0000u); v[2] = __builtin_bit_cast(float, w.y << 16); v[3] = __builtin_bit_cast(float, w.y & 0xffff0000u);
    v[4] = __builtin_bit_cast(float, w.z << 16); v[5] = __builtin_bit_cast(float, w.z & 0xffff0000u); v[6] = __builtin_bit_cast(float, w.w << 16); v[7] = __builtin_bit_cast(float, w.w & 0xffff0000u);
}
__device__ __forceinline__ v4u pack8(const float (&v)[8]) { v4u o; o.x = pk2(v[0], v[1]); o.y = pk2(v[2], v[3]); o.z = pk2(v[4], v[5]); o.w = pk2(v[6], v[7]); return o; }
__device__ __forceinline__ float gelu_tanh_f(float x) { return pg8::gelu_tanh(x); }

__device__ __forceinline__ void tr_item(const float* W, int ldw, int K, bf16* WT, int src_col0, int dst_row0, int kb, LAS float* scr, int lane) {
    const int k0 = 64 * kb;
#pragma unroll 8
    for (int i = 0; i < 32; ++i) { const int kk = 2 * i + (lane >> 5); scr[kk * 33 + (lane & 31)] = W[(size_t)(k0 + kk) * ldw + src_col0 + (lane & 31)]; }
    LDS_WAIT(); asm volatile("" ::: "memory");
    const int c = lane & 7;
#pragma unroll
    for (int j = 0; j < 4; ++j) { const int n = (lane >> 3) + 8 * j; const LAS float* s = scr + (8 * c) * 33 + n;
        v4u o; o.x = pk2(s[0 * 33], s[1 * 33]); o.y = pk2(s[2 * 33], s[3 * 33]); o.z = pk2(s[4 * 33], s[5 * 33]); o.w = pk2(s[6 * 33], s[7 * 33]);
        *(GAS v4u*)(WT + (size_t)(dst_row0 + n) * K + k0 + 8 * c) = o; }
    LDS_WAIT(); asm volatile("" ::: "memory");
}
__device__ __forceinline__ float log_sigmoid_f(float z) { return z >= 0.f ? -log1pf(expf(-z)) : z - log1pf(expf(z)); }
__device__ __forceinline__ void p0_prologue(Frame& F) {
    LAS float* scr = (LAS float*)(F.lds + RING_OFF + F.wave * 16384);
    const int gw = F.vcu * NWAVES + F.wave, NGW = F.G * NWAVES, lane = F.lane;
    unsigned char* ws = F.ws;
    constexpr int I0 = 16 * 80, I1 = 16 * 32, I2 = 16 * 64, I3 = 16 * 32, I4 = 16 * 176, I5 = I4, I6 = 44 * 32, I7 = I6, NITEMS = I0 + I1 + I2 + I3 + I4 + I5 + I6 + I7;
    for (int it = gw; it < NITEMS; it += NGW) {
        int r = it;
        if (r < I0) { const int kb = r / 80, nb = r % 80; const int dst = 32 * nb, src = dst < 1536 ? dst : dst + 8; tr_item(INP(I_WINE), ECOLS, D, (bf16*)(ws + WS_WINE), src, dst, kb, scr, lane); continue; } r -= I0;
        if (r < I1) { tr_item(INP(I_WOUTE), D, D, (bf16*)(ws + WS_WOUTE), 32 * (r % 32), 32 * (r % 32), r / 32, scr, lane); continue; } r -= I1;
        if (r < I2) { tr_item(INP(I_WINO), 2 * D, D, (bf16*)(ws + WS_WINO), 32 * (r % 64), 32 * (r % 64), r / 64, scr, lane); continue; } r -= I2;
        if (r < I3) { tr_item(INP(I_WOUTO), D, D, (bf16*)(ws + WS_WOUTO), 32 * (r % 32), 32 * (r % 32), r / 32, scr, lane); continue; } r -= I3;
        if (r < I4) { tr_item(INP(I_WUP), FF2, D, (bf16*)(ws + WS_WUP0), 32 * (r % 176), 32 * (r % 176), r / 176, scr, lane); continue; } r -= I4;
        if (r < I5) { tr_item(INP(I_WUP) + (size_t)D * FF2, FF2, D, (bf16*)(ws + WS_WUP1), 32 * (r % 176), 32 * (r % 176), r / 176, scr, lane); continue; } r -= I5;
        if (r < I6) { tr_item(INP(I_WDN), D, FF, (bf16*)(ws + WS_WDN0), 32 * (r % 32), 32 * (r % 32), r / 32, scr, lane); continue; } r -= I6;
        tr_item(INP(I_WDN) + (size_t)FF * D, D, FF, (bf16*)(ws + WS_WDN1), 32 * (r % 32), 32 * (r % 32), r / 32, scr, lane);
    }
    const float* wf = INP(I_WINE) + 1536; const float* bfp = INP(I_BF);
    for (int m = gw; m < M; m += NGW) {
        const float* xrow = m < MP ? INP(I_XP) + (size_t)m * D : INP(I_XS) + (size_t)(m - MP) * D;
        const GAS f32x4* xr = (const GAS f32x4*)xrow + lane;
        f32x4 v[4];
#pragma unroll
        for (int j = 0; j < 4; ++j) v[j] = xr[64 * j];
        GAS unsigned long long* o8 = (GAS unsigned long long*)((bf16*)(ws + WS_XA) + (size_t)m * D) + lane;
#pragma unroll
        for (int j = 0; j < 4; ++j) o8[64 * j] = (unsigned long long)pk2(v[j].x, v[j].y) | ((unsigned long long)pk2(v[j].z, v[j].w) << 32);
        float f0 = 0.f, f1 = 0.f, f2 = 0.f, f3 = 0.f, f4 = 0.f, f5 = 0.f, f6 = 0.f, f7 = 0.f;
#pragma unroll
        for (int j = 0; j < 4; ++j)
#pragma unroll
            for (int e = 0; e < 4; ++e) { const int k = 4 * lane + 256 * j + e; const GAS f32x4* wr = (const GAS f32x4*)(wf + (size_t)k * ECOLS); const f32x4 wa = wr[0], wb = wr[1]; const float xv = v[j][e];
                f0 += xv * wa.x; f1 += xv * wa.y; f2 += xv * wa.z; f3 += xv * wa.w; f4 += xv * wb.x; f5 += xv * wb.y; f6 += xv * wb.z; f7 += xv * wb.w; }
        f0 = wave_sum(f0); f1 = wave_sum(f1); f2 = wave_sum(f2); f3 = wave_sum(f3); f4 = wave_sum(f4); f5 = wave_sum(f5); f6 = wave_sum(f6); f7 = wave_sum(f7);
        if (lane < 8) { float fv = f0; fv = lane == 1 ? f1 : fv; fv = lane == 2 ? f2 : fv; fv = lane == 3 ? f3 : fv; fv = lane == 4 ? f4 : fv; fv = lane == 5 ? f5 : fv; fv = lane == 6 ? f6 : fv; fv = lane == 7 ? f7 : fv;
            const float lf = log_sigmoid_f(fv + bfp[lane]);
            if (m < MP) F.out[O_LFP + (size_t)m * NH + lane] = lf; else F.out[O_LFS + (size_t)(m - MP) * NH + lane] = lf; }
    }
    { const size_t n8 = (size_t)NBS * PAST * AW / 8; const size_t gt = (size_t)F.vcu * 512 + F.tid, NT = (size_t)F.G * 512;
      const GAS f32x4* ck = (const GAS f32x4*)INP(I_CK); const GAS f32x4* cv = (const GAS f32x4*)INP(I_CV); GAS v4u* kc = (GAS v4u*)(ws + WS_KC); GAS v4u* vc = (GAS v4u*)(ws + WS_VC);
      for (size_t i = gt; i < n8; i += NT) { const f32x4 a = ck[2 * i], b = ck[2 * i + 1], c = cv[2 * i], d = cv[2 * i + 1];
          v4u o; o.x = pk2(a.x, a.y); o.y = pk2(a.z, a.w); o.z = pk2(b.x, b.y); o.w = pk2(b.z, b.w); kc[i] = o;
          v4u p; p.x = pk2(c.x, c.y); p.y = pk2(c.z, c.w); p.z = pk2(d.x, d.y); p.w = pk2(d.z, d.w); vc[i] = p; } }
}

__device__ __forceinline__ void p2_scans(Frame& F) {
    const int gw = F.vcu * NWAVES + F.wave, NGW = F.G * NWAVES, lane = F.lane;
    float* KBP = (float*)(F.ws + WS_KBP); float* KBS = (float*)(F.ws + WS_KBS);
    for (int it = gw; it < 32 + 256; it += NGW) {
        if (it < 32) { const int b = it >> 3, h = it & 7; const float* lf = F.out + O_LFP + (size_t)b * TP * NH + h;
            double s = 0.0;
            for (int i = 0; i < 64; ++i) s += (double)lf[(size_t)(64 * lane + i) * NH];
            double inc = s;
#pragma unroll
            for (int o = 1; o < 64; o <<= 1) { const double t = __shfl_up(inc, o); if (lane >= o) inc += t; }
            double run = inc - s;
            for (int i = 0; i < 64; ++i) { run += (double)lf[(size_t)(64 * lane + i) * NH]; KBP[(size_t)it * TP + 64 * lane + i] = (float)(-run * 1.4426950408889634); }
        } else { const int sid = it - 32, b = sid >> 3, h = sid & 7;
            { double inc = (double)F.out[O_LFS + (size_t)(b * TS + lane) * NH + h];
#pragma unroll
              for (int o = 1; o < 64; o <<= 1) { const double t = __shfl_up(inc, o); if (lane >= o) inc += t; }
              KBS[(size_t)sid * 2112 + PAST + lane] = (float)(-inc * 1.4426950408889634); }
            const float* lc = INP(I_CLF) + (size_t)b * PAST * NH + h;
            double s = 0.0;
            for (int i = 0; i < 32; ++i) s += (double)lc[(size_t)(32 * lane + i) * NH];
            double inc = s;
#pragma unroll
            for (int o = 1; o < 64; o <<= 1) { const double t = __shfl_down(inc, o); if (lane + o < 64) inc += t; }
            double run = inc - s;
            for (int i = 31; i >= 0; --i) { const int sx = 32 * lane + i; KBS[(size_t)sid * 2112 + sx] = (float)(run * 1.4426950408889634); run += (double)lc[(size_t)sx * NH]; }
        }
    }
}

__device__ __forceinline__ void rg_item(Frame& F, int it, int pass) {
    LAS float* xs = (LAS float*)(F.lds + RING_OFF); LAS float* xc = xs + 4352; LAS float* was = xc + 4160; LAS float* wxs = was + 4096; LAS float* sa = wxs + 4096; LAS float* su = sa + 4096;
    LAS float* sA = su + 4096; LAS float* sH = sA + 512; LAS float* ssp = sH + 512;
    int b, n, chunk, row0; bool samp;
    if (it < 2048) { chunk = it & 63; n = (it >> 6) & 7; b = it >> 9; row0 = b * TP + chunk * 64; samp = false; }
    else { const int s = it - 2048; n = s & 7; b = s >> 3; chunk = 0; row0 = MP + b * TS; samp = true; }
    const int tid = F.tid;
    const bf16* XB = (const bf16*)(F.ws + WS_XB); const bf16* GB = (const bf16*)(F.ws + WS_GB); bf16* MIX = (bf16*)(F.ws + WS_MIX);
    float* CA = (float*)(F.ws + WS_CARRY); float* CH = CA + 2304 * 64;
    for (int e = tid; e < 67 * 8; e += 512) { const int r = e >> 3, c8 = (e & 7) * 8, t = r - 3; float v[8];
        if (chunk == 0 && t < 0) {
            if (samp) { const float* sp = INP(I_SRC) + ((size_t)b * 3 + r) * BW + n * 64 + c8;
#pragma unroll
                for (int i = 0; i < 8; ++i) v[i] = sp[i]; }
            else {
#pragma unroll
                for (int i = 0; i < 8; ++i) v[i] = 0.f; } }
        else { const v4u w = *(const GAS v4u*)(XB + (size_t)(row0 + t) * BW + n * 64 + c8); unpack8(w, v); }
#pragma unroll
        for (int i = 0; i < 8; ++i) xs[r * 64 + c8 + i] = v[i]; }
    for (int e = tid; e < 4096; e += 512) { was[e] = INP(I_RWA)[n * 4096 + e]; wxs[e] = INP(I_RWX)[n * 4096 + e]; }
    if (tid < 64) { const float lam = INP(I_RLAM)[n * 64 + tid]; ssp[tid] = log1pf(expf(-lam)); }
    __syncthreads();
    for (int e = tid; e < 4096; e += 512) { const int t = e >> 6, c = e & 63, ch = n * 64 + c; const float* cw = INP(I_RCW);
        xc[t * 65 + c] = INP(I_RCB)[ch] + cw[ch] * xs[t * 64 + c] + cw[BW + ch] * xs[(t + 1) * 64 + c] + cw[2 * BW + ch] * xs[(t + 2) * 64 + c] + cw[3 * BW + ch] * xs[(t + 3) * 64 + c]; }
    __syncthreads();
    { const int t = tid >> 3, d0 = (tid & 7) * 8; float ar[8], ai[8];
#pragma unroll
      for (int i = 0; i < 8; ++i) { ar[i] = INP(I_RBA)[n * 64 + d0 + i]; ai[i] = INP(I_RBX)[n * 64 + d0 + i]; }
      for (int c = 0; c < 64; ++c) { const float x = xc[t * 65 + c]; const LAS float* wr = was + c * 64 + d0; const LAS float* wi = wxs + c * 64 + d0;
#pragma unroll
          for (int i = 0; i < 8; ++i) { ar[i] += x * wr[i]; ai[i] += x * wi[i]; } }
#pragma unroll
      for (int i = 0; i < 8; ++i) { const int d = d0 + i; const float gr = 1.f / (1.f + expf(-ar[i])), gi = 1.f / (1.f + expf(-ai[i])); const float la = -8.f * gr * ssp[d];
          sa[t * 64 + d] = expf(la); su[t * 64 + d] = sqrtf(-expm1f(2.f * la)) * gi * xc[t * 65 + d]; } }
    __syncthreads();
    const int sub = tid >> 6, c = tid & 63;
    { float A = 1.f, H = 0.f;
#pragma unroll
      for (int i = 0; i < 8; ++i) { const int t = sub * 8 + i; const float a = sa[t * 64 + c]; H = a * H + su[t * 64 + c]; A *= a; }
      sA[sub * 64 + c] = A; sH[sub * 64 + c] = H; }
    __syncthreads();
    if (pass == 1) {
        if (sub == 7) { float At = 1.f, Ht = 0.f;
#pragma unroll
            for (int s = 0; s < 8; ++s) { const float a = sA[s * 64 + c]; Ht = a * Ht + sH[s * 64 + c]; At *= a; }
            CA[(size_t)it * 64 + c] = At; CH[(size_t)it * 64 + c] = Ht; }
    } else {
        float h = samp ? INP(I_SRH)[(size_t)b * BW + n * 64 + c] : 0.f;
        for (int cc = 0; cc < chunk; ++cc) { const size_t pit = (size_t)(it - chunk + cc) * 64 + c; h = CA[pit] * h + CH[pit]; }
        for (int s = 0; s < sub; ++s) h = sA[s * 64 + c] * h + sH[s * 64 + c];
#pragma unroll
        for (int i = 0; i < 8; ++i) { const int t = sub * 8 + i; h = sa[t * 64 + c] * h + su[t * 64 + c]; const size_t row = (size_t)row0 + t;
            const float g = bf2f(GB[row * BW + n * 64 + c]); MIX[row * D + AW + n * 64 + c] = (bf16)f2bf(g * h);
            if (t == 63 && (samp || chunk == 63)) F.out[(samp ? O_RHS : O_RHP) + (size_t)b * BW + n * 64 + c] = h; }
    }
    __syncthreads();
}

namespace att {
typedef short bf16x8 __attribute__((ext_vector_type(8)));
typedef short s16x4 __attribute__((ext_vector_type(4)));
typedef float f32x16 __attribute__((ext_vector_type(16)));
typedef unsigned u32x4 __attribute__((ext_vector_type(4)));
typedef float f32x2_t __attribute__((ext_vector_type(2))); typedef __bf16 bf16x2_t __attribute__((ext_vector_type(2)));
__device__ __forceinline__ int crow(int r, int hi) { return (r & 3) + 8 * (r >> 2) + 4 * hi; }
__device__ __forceinline__ unsigned cvtpk_s(float lo, float hi) { f32x2_t v = {lo, hi}; bf16x2_t b = __builtin_convertvector(v, bf16x2_t); return __builtin_bit_cast(unsigned, b); }
__device__ __forceinline__ s16x4 vtr(const LAS char* p) { return __builtin_bit_cast(s16x4, __builtin_amdgcn_ds_read_tr16_b64_v4i16((LAS s16x4*)p)); }
__device__ __forceinline__ void qkt(f32x16& p0, f32x16& p1, const LAS char* Kslot, const bf16x8 (&qr)[4], int r32, int hi) {
    const LAS char* kb = Kslot + hi * 1024 + r32 * 16;
    f32x16 z0 = {}, z1 = {};
#pragma unroll
    for (int d0 = 0; d0 < 4; ++d0) { const bf16x8 b0 = *(const LAS bf16x8*)(kb + d0 * 2048); const bf16x8 b1 = *(const LAS bf16x8*)(kb + d0 * 2048 + 512);
        z0 = __builtin_amdgcn_mfma_f32_32x32x16_bf16(b0, qr[d0], z0, 0, 0, 0); z1 = __builtin_amdgcn_mfma_f32_32x32x16_bf16(b1, qr[d0], z1, 0, 0, 0); }
    p0 = z0; p1 = z1;
}
__device__ __forceinline__ void pv(f32x16 (&o)[2], const LAS char* vp, bf16x8 pa0, bf16x8 pa1, bf16x8 pa2, bf16x8 pa3) {
#pragma unroll
    for (int d0 = 0; d0 < 2; ++d0) { bf16x8 vf[4];
#pragma unroll
        for (int ks = 0; ks < 4; ++ks) { const s16x4 lo = vtr(vp + d0 * 4096 + ks * 1024), hi = vtr(vp + d0 * 4096 + ks * 1024 + 512); vf[ks] = (bf16x8){lo[0], lo[1], lo[2], lo[3], hi[0], hi[1], hi[2], hi[3]}; }
        o[d0] = __builtin_amdgcn_mfma_f32_32x32x16_bf16(pa0, vf[0], o[d0], 0, 0, 0); o[d0] = __builtin_amdgcn_mfma_f32_32x32x16_bf16(pa1, vf[1], o[d0], 0, 0, 0);
        o[d0] = __builtin_amdgcn_mfma_f32_32x32x16_bf16(pa2, vf[2], o[d0], 0, 0, 0); o[d0] = __builtin_amdgcn_mfma_f32_32x32x16_bf16(pa3, vf[3], o[d0], 0, 0, 0); }
}
struct KV { const bf16* k0; const bf16* v0; const bf16* k1; const bf16* v1; int nt0; };
__device__ __forceinline__ void unit(LAS unsigned char* lds, int tid, const bf16* Qrows, int nqw, const KV S, int NT, const float* kbias, int qpos0, bf16* Odst) {
    const int lane = tid & 63, wid = __builtin_amdgcn_readfirstlane(tid >> 6), r32 = lane & 31, hi = lane >> 5;
    const bool active = wid < nqw;
    LAS char* Kb = (LAS char*)lds; LAS char* Vb = Kb + 16384; LAS float* wsf = (LAS float*)(Kb + 32768) + wid * 64; LAS bf16* stg = (LAS bf16*)(Kb + 32768 + 2048) + wid * 2048;
    bf16x8 qr[4];
#pragma unroll
    for (int d0 = 0; d0 < 4; ++d0) qr[d0] = active ? *(const GAS bf16x8*)(Qrows + (size_t)(wid * 32 + r32) * 512 + d0 * 16 + hi * 8) : (bf16x8){0, 0, 0, 0, 0, 0, 0, 0};
    float m_run = -INFINITY, l_run = 0.f; f32x16 o[2]; o[0] = f32x16{}; o[1] = f32x16{};
    const int qlo = qpos0 + wid * 32, qhi = qlo + 31, qpos = qlo + r32;
    const size_t koff = (size_t)lane * 512 + wid * 8, voff = (size_t)(16 * (wid & 3) + (lane >> 2)) * 512 + (wid >> 2) * 32 + (lane & 3) * 8;
    const int ldst = wid * 1024 + lane * 16;
    const LAS char* vp0 = Vb + ((lane >> 4) & 1) * 32 + (lane & 3) * 8 + (4 * hi + ((lane & 15) >> 2)) * 64;
    u32x4 kreg, vreg;
    { const bf16* kt = S.nt0 > 0 ? S.k0 : S.k1; const bf16* vt = S.nt0 > 0 ? S.v0 : S.v1; kreg = *(const GAS u32x4*)(kt + koff); vreg = *(const GAS u32x4*)(vt + voff); }
    *(LAS u32x4*)(Kb + ldst) = kreg; *(LAS u32x4*)(Vb + ldst) = vreg;
    __syncthreads();
    for (int t = 0; t < NT; ++t) {
        const int slot = (t & 1) * 8192;
        if (t + 1 < NT) { const int tn = t + 1; const bf16* kt = tn < S.nt0 ? S.k0 + (size_t)tn * 64 * 512 : S.k1 + (size_t)(tn - S.nt0) * 64 * 512; const bf16* vt = tn < S.nt0 ? S.v0 + (size_t)tn * 64 * 512 : S.v1 + (size_t)(tn - S.nt0) * 64 * 512;
            kreg = *(const GAS u32x4*)(kt + koff); vreg = *(const GAS u32x4*)(vt + voff); }
        if (active && 64 * t <= qhi) {
            f32x16 p0, p1; qkt(p0, p1, Kb + slot, qr, r32, hi);
            const float* kbt = kbias + 64 * t + 4 * hi;
#pragma unroll
            for (int g = 0; g < 4; ++g) { const f32x4 b0 = *(const GAS f32x4*)(kbt + 8 * g), b1 = *(const GAS f32x4*)(kbt + 32 + 8 * g);
#pragma unroll
                for (int e = 0; e < 4; ++e) { p0[4 * g + e] += b0[e]; p1[4 * g + e] += b1[e]; } }
            if (64 * t + 63 > qlo) {
#pragma unroll
                for (int r = 0; r < 16; ++r) { const int kv = 64 * t + crow(r, hi); if (kv > qpos) p0[r] = -INFINITY; if (kv + 32 > qpos) p1[r] = -INFINITY; } }
            float rm = fmaxf(p0[0], p1[0]);
#pragma unroll
            for (int r = 1; r < 16; ++r) rm = fmaxf(rm, fmaxf(p0[r], p1[r]));
            rm = fmaxf(rm, __shfl_xor(rm, 32));
            const float mn = fmaxf(m_run, rm); const float f = __builtin_amdgcn_exp2f(m_run - mn); m_run = mn;
            float rs = 0.f;
#pragma unroll
            for (int r = 0; r < 16; ++r) { p0[r] = __builtin_amdgcn_exp2f(p0[r] - mn); p1[r] = __builtin_amdgcn_exp2f(p1[r] - mn); rs += p0[r] + p1[r]; }
            l_run = l_run * f + rs;
            if (hi == 0) wsf[r32] = f;
#pragma unroll
            for (int r = 0; r < 16; ++r) { const float fr_ = wsf[crow(r, hi)]; o[0][r] *= fr_; o[1][r] *= fr_; }
            u32x4 pw0, pw1, pw2, pw3;
            pw0 = (u32x4){cvtpk_s(p0[0], p0[1]), cvtpk_s(p0[2], p0[3]), cvtpk_s(p0[4], p0[5]), cvtpk_s(p0[6], p0[7])}; pw1 = (u32x4){cvtpk_s(p0[8], p0[9]), cvtpk_s(p0[10], p0[11]), cvtpk_s(p0[12], p0[13]), cvtpk_s(p0[14], p0[15])};
            pw2 = (u32x4){cvtpk_s(p1[0], p1[1]), cvtpk_s(p1[2], p1[3]), cvtpk_s(p1[4], p1[5]), cvtpk_s(p1[6], p1[7])}; pw3 = (u32x4){cvtpk_s(p1[8], p1[9]), cvtpk_s(p1[10], p1[11]), cvtpk_s(p1[12], p1[13]), cvtpk_s(p1[14], p1[15])};
            pv(o, vp0 + slot, __builtin_bit_cast(bf16x8, pw0), __builtin_bit_cast(bf16x8, pw1), __builtin_bit_cast(bf16x8, pw2), __builtin_bit_cast(bf16x8, pw3));
        }
        if (t + 1 < NT) { const int ns = ((t + 1) & 1) * 8192; *(LAS u32x4*)(Kb + ns + ldst) = kreg; *(LAS u32x4*)(Vb + ns + ldst) = vreg; }
        __syncthreads();
    }
    if (active) {
        const float lt = l_run + __shfl_xor(l_run, 32);
        if (hi == 0) wsf[32 + r32] = lt;
#pragma unroll
        for (int r = 0; r < 16; ++r) { const int orow = crow(r, hi); const float rl = 1.0f / wsf[32 + orow];
            stg[orow * 64 + r32] = (bf16)f2bf(o[0][r] * rl); stg[orow * 64 + 32 + r32] = (bf16)f2bf(o[1][r] * rl); }
#pragma unroll
        for (int i = 0; i < 4; ++i) { const int row = i * 8 + (lane >> 3), ch = lane & 7; const u32x4 v = *(const LAS u32x4*)(stg + row * 64 + ch * 8); *(GAS u32x4*)(Odst + (size_t)(wid * 32 + row) * D + ch * 8) = v; }
    }
    __syncthreads();
}
}

__device__ __forceinline__ void p3_mixer(Frame& F) {
    const bf16* Q = (const bf16*)(F.ws + WS_Q); const bf16* K = (const bf16*)(F.ws + WS_K); const bf16* V = (const bf16*)(F.ws + WS_V); bf16* MIX = (bf16*)(F.ws + WS_MIX);
    const bf16* KC = (const bf16*)(F.ws + WS_KC); const bf16* VC = (const bf16*)(F.ws + WS_VC);
    const float* KBP = (const float*)(F.ws + WS_KBP); const float* KBS = (const float*)(F.ws + WS_KBS);
    for (int i = F.vcu; i < 512; i += F.G) { const int j = i & 255, bh = j >> 3, s = j & 7, qb = i < 256 ? 15 - s : s, b = bh >> 3, h = bh & 7;
        const size_t r0 = (size_t)b * TP; att::KV S{K + r0 * AW + h * 64, V + r0 * AW + h * 64, K + r0 * AW + h * 64, V + r0 * AW + h * 64, 4 * qb + 4};
        att::unit(F.lds + RING_OFF, F.tid, Q + (r0 + 256 * qb) * AW + h * 64, 8, S, 4 * qb + 4, KBP + (size_t)bh * TP, 256 * qb, MIX + (r0 + 256 * qb) * D + h * 64); }
    for (int i = F.vcu; i < 256; i += F.G) { const int b = i >> 3, h = i & 7; const size_t r0 = (size_t)MP + (size_t)b * TS, c0 = (size_t)b * PAST;
        att::KV S{KC + c0 * AW + h * 64, VC + c0 * AW + h * 64, K + r0 * AW + h * 64, V + r0 * AW + h * 64, 32};
        att::unit(F.lds + RING_OFF, F.tid, Q + r0 * AW + h * 64, 2, S, 33, KBS + (size_t)i * 2112, PAST, MIX + r0 * D + h * 64); }
    for (int it = F.vcu; it < 2304; it += F.G) rg_item(F, it, 2);
}

__device__ __forceinline__ void ln_phase(Frame& F, const float* resP, const float* resS, const float* Y, const float* g, const float* bta, float* oP, float* oS, bf16* o16) {
    const int gw = F.vcu * NWAVES + F.wave, NGW = F.G * NWAVES, lane = F.lane;
    f32x4 gv[4], bv[4];
#pragma unroll
    for (int j = 0; j < 4; ++j) { gv[j] = ((const GAS f32x4*)g)[lane + 64 * j]; bv[j] = ((const GAS f32x4*)bta)[lane + 64 * j]; }
    for (int m = gw; m < M; m += NGW) {
        const float* rrow = m < MP ? resP + (size_t)m * D : resS + (size_t)(m - MP) * D; float* orow = m < MP ? oP + (size_t)m * D : oS + (size_t)(m - MP) * D;
        const GAS f32x4* rr = (const GAS f32x4*)rrow + lane; const GAS f32x4* yr = (const GAS f32x4*)(Y + (size_t)m * D) + lane;
        f32x4 v[4]; float s = 0.f;
#pragma unroll
        for (int j = 0; j < 4; ++j) { v[j] = rr[64 * j] * ALPHA + yr[64 * j]; s += (v[j].x + v[j].y) + (v[j].z + v[j].w); }
        const float mean = wave_sum(s) * (1.f / D); float s2 = 0.f;
#pragma unroll
        for (int j = 0; j < 4; ++j) { v[j] = v[j] - mean; s2 += (v[j].x * v[j].x + v[j].y * v[j].y) + (v[j].z * v[j].z + v[j].w * v[j].w); }
        const float rstd = 1.f / sqrtf(wave_sum(s2) * (1.f / D) + LN_EPS);
        GAS f32x4* o4 = (GAS f32x4*)orow + lane; GAS unsigned long long* o8 = (GAS unsigned long long*)(o16 + (size_t)m * D) + lane;
#pragma unroll
        for (int j = 0; j < 4; ++j) { const f32x4 r = v[j] * rstd * gv[j] + bv[j]; o4[64 * j] = r; if (o16) o8[64 * j] = (unsigned long long)pk2(r.x, r.y) | ((unsigned long long)pk2(r.z, r.w) << 32); }
    }
}
__device__ __forceinline__ void vln_phase(Frame& F) {
    const int gw = F.vcu * NWAVES + F.wave, NGW = F.G * NWAVES, lane = F.lane;
    const float* VR = (const float*)(F.ws + WS_VR); bf16* VN = (bf16*)(F.ws + WS_VN);
    f32x4 gv[4], bv[4];
#pragma unroll
    for (int j = 0; j < 4; ++j) { gv[j] = ((const GAS f32x4*)INP(I_SGG))[lane + 64 * j]; bv[j] = ((const GAS f32x4*)INP(I_SGB))[lane + 64 * j]; }
    for (int m = gw; m < M; m += NGW) {
        const GAS f32x4* yr = (const GAS f32x4*)(VR + (size_t)m * D) + lane;
        f32x4 v[4]; float s = 0.f;
#pragma unroll
        for (int j = 0; j < 4; ++j) { v[j] = yr[64 * j]; s += (v[j].x + v[j].y) + (v[j].z + v[j].w); }
        const float mean = wave_sum(s) * (1.f / D); float s2 = 0.f;
#pragma unroll
        for (int j = 0; j < 4; ++j) { v[j] = v[j] - mean; s2 += (v[j].x * v[j].x + v[j].y * v[j].y) + (v[j].z * v[j].z + v[j].w * v[j].w); }
        const float rstd = 1.f / sqrtf(wave_sum(s2) * (1.f / D) + LN_EPS);
        GAS unsigned long long* o8 = (GAS unsigned long long*)(VN + (size_t)m * D) + lane;
#pragma unroll
        for (int j = 0; j < 4; ++j) { const f32x4 r = v[j] * rstd * gv[j] + bv[j]; o8[64 * j] = (unsigned long long)pk2(r.x, r.y) | ((unsigned long long)pk2(r.z, r.w) << 32);
            if (m >= MP) ((GAS f32x4*)(F.out + O_SGV + (size_t)(m - MP) * D))[lane + 64 * j] = r; }
    }
}
__device__ __forceinline__ void convgate_phase(Frame& F, int layer) {
    const bf16* H = (const bf16*)(F.ws + WS_H); bf16* ACT = (bf16*)(F.ws + WS_ACT);
    const float* cw = INP(I_FCW) + (size_t)layer * 3 * FF2; const float* cb = INP(I_FCB) + (size_t)layer * FF2; const float* st = INP(I_SFC) + (size_t)layer * NBS * 2 * FF2;
    const size_t gt = (size_t)F.vcu * 512 + F.tid, NTH = (size_t)F.G * 512, NIT = (size_t)M * (FF / 8);
    for (size_t idx = gt; idx < NIT; idx += NTH) { const int row = (int)(idx / (FF / 8)), cc = (int)(idx % (FF / 8)) * 8;
        int t, b; bool samp; if (row < MP) { t = row & (TP - 1); b = row >> 12; samp = false; } else { const int rs = row - MP; t = rs & (TS - 1); b = rs >> 6; samp = true; }
        float res[2][8];
#pragma unroll
        for (int part = 0; part < 2; ++part) { const int c = cc + part * FF; float h0[8], h1[8], h2[8];
            unpack8(*(const GAS v4u*)(H + (size_t)row * FF2 + c), h2);
            if (t >= 1) unpack8(*(const GAS v4u*)(H + (size_t)(row - 1) * FF2 + c), h1);
            else {
#pragma unroll
                for (int i = 0; i < 8; ++i) h1[i] = samp ? st[((size_t)b * 2 + 1) * FF2 + c + i] : 0.f; }
            if (t >= 2) unpack8(*(const GAS v4u*)(H + (size_t)(row - 2) * FF2 + c), h0);
            else {
#pragma unroll
                for (int i = 0; i < 8; ++i) h0[i] = samp ? st[((size_t)b * 2 + t) * FF2 + c + i] : 0.f; }
#pragma unroll
            for (int i = 0; i < 8; ++i) res[part][i] = cb[c + i] + cw[c + i] * h0[i] + cw[FF2 + c + i] * h1[i] + cw[2 * FF2 + c + i] * h2[i]; }
        float a[8];
#pragma unroll
        for (int i = 0; i < 8; ++i) a[i] = gelu_tanh_f(res[0][i]) * res[1][i];
        *(GAS v4u*)(ACT + (size_t)row * FF + cc) = pack8(a); }
}
__device__ __forceinline__ void sgu_phase(Frame& F) {
    LAS float* vt = (LAS float*)(F.lds + RING_OFF); LAS float* wt = vt + 128 * 128;
    const bf16* VN = (const bf16*)(F.ws + WS_VN); const bf16* U = (const bf16*)(F.ws + WS_U); bf16* G = (bf16*)(F.ws + WS_G);
    const int tid = F.tid;
    for (int it = F.vcu; it < (128 + 32) * 8; it += F.G) { const int g = it & 7, ci = it >> 3; const int L = ci < 128 ? 128 : 64; const int row0 = ci < 128 ? ci * 128 : MP + (ci - 128) * 64;
        for (int e = tid; e < L * 16; e += 512) { const int s = e >> 4, c8 = (e & 15) * 8; float v[8]; unpack8(*(const GAS v4u*)(VN + (size_t)(row0 + s) * D + g * 128 + c8), v);
#pragma unroll
            for (int i = 0; i < 8; ++i) vt[s * 128 + c8 + i] = v[i]; }
        for (int e = tid; e < L * 128; e += 512) { const int t = e >> 7, s = e & 127; if (s < L) wt[t * 128 + s] = INP(I_SGW)[((size_t)g * 128 + t) * 128 + s]; }
        __syncthreads();
        const int c = tid & 127, tq = tid >> 7;
        for (int t = tq; t < L; t += 4) { float acc = INP(I_SGBIAS)[g * 128 + t];
            for (int s = 0; s <= t; ++s) acc += wt[t * 128 + s] * vt[s * 128 + c];
            const size_t o = (size_t)(row0 + t) * D + g * 128 + c; G[o] = (bf16)f2bf(bf2f(U[o]) * acc); }
        __syncthreads(); }
}
#ifndef MK_N_LAUNCHES
#define MK_N_LAUNCHES 1
#endif
constexpr int PER_PHASE = 19;
constexpr int N_LAUNCHES = MK_N_LAUNCHES;
struct Args { const float* in[32]; float* out; unsigned char* ws; int ph_lo, ph_hi, li, pad; };
static_assert(sizeof(Args) == 32 * 8 + 8 + 8 + 16, "Args has no padding bytes");

__global__ void __launch_bounds__(NWAVES * 64, 2) fwd_kernel(Args args) {
    extern __shared__ __attribute__((aligned(16))) unsigned char lds[];
    Frame F;
    F.lds = (LAS unsigned char*)lds;
    F.MISC = (volatile LAS unsigned*)(F.lds + MISC_OFF);
    F.tid = threadIdx.x; F.lane = F.tid & 63; F.wave = __builtin_amdgcn_readfirstlane(F.tid >> 6);
    F.G = gridDim.x; { const int bx = blockIdx.x; F.vcu = (F.G % 8 == 0) ? (bx % 8) * (F.G / 8) + bx / 8 : bx; }
    F.out = args.out; F.ws = args.ws; F.ctl = (gu32*)(args.ws + WS_CTL);
    unsigned char* ws = args.ws;
    for (int u = F.tid; u < (LDS_BYTES - LDSCTL_OFF) / 4; u += NWAVES * 64) ((LAS unsigned*)(F.lds + LDSCTL_OFF))[u] = 0u;
    __syncthreads();
    XcdBarrier bar; bar.bar = (unsigned*)(F.ctl + CW_BAR); bar.x = 0; bar.st = nullptr;
    if (N_LAUNCHES != PER_PHASE) bar = xcd_barrier_post((unsigned*)(F.ctl + CW_BAR), F.MISC + 8);
#define GRID_BAR(seam) do { if (N_LAUNCHES == PER_PHASE) { if (F.tid == 0) __hip_atomic_store(F.ctl + CW_TMO, 0xBADBA0u | (unsigned)(seam), RLX_AGENT); } else { xcd_barrier(bar); } } while (0)
    const int lo = args.ph_lo, hi = args.ph_hi;
#define IN(k) (lo <= (k) && (k) < hi)
#define SEAM(k) do { if (IN(k) && IN((k) + 1)) GRID_BAR(k); } while (0)
    bf16* XA = (bf16*)(ws + WS_XA); float* XR = (float*)(ws + WS_XR); float* Y = (float*)(ws + WS_Y); bf16* H = (bf16*)(ws + WS_H); bf16* ACT = (bf16*)(ws + WS_ACT);
    float* out = args.out;
    const int cblk = (int)blockIdx.x;

    if (IN(0)) { p0_prologue(F); SEAM(0); }
    if (IN(1)) {
        pg8::Gemm g{XA, (const bf16*)(ws + WS_WINE), M, NE, D}; pg8::StaticOrder S; S.init(M, NE, F.G, cblk);
        pg8::EpiInE E{(bf16*)(ws + WS_Q), (bf16*)(ws + WS_K), (bf16*)(ws + WS_V), (bf16*)(ws + WS_XB), (bf16*)(ws + WS_GB), out + O_KP, out + O_VP, out + O_KS, out + O_VS, out + O_RCP, out + O_RCS, QSCALE};
        pg8::gemm_phase<pg8::EpiInE, pg8::StaticOrder, true, true>(F.lds + RING_OFF, g, S, E); SEAM(1); }
    if (IN(2)) { p2_scans(F); for (int it = F.vcu; it < 2304; it += F.G) rg_item(F, it, 1); SEAM(2); }
    if (IN(3)) { p3_mixer(F); SEAM(3); }
    if (IN(4)) {
        pg8::Gemm g{(const bf16*)(ws + WS_MIX), (const bf16*)(ws + WS_WOUTE), M, D, D}; pg8::StaticOrder S; S.init(M, D, F.G, cblk); pg8::EpiF32 E{Y, D};
        pg8::gemm_phase<pg8::EpiF32, pg8::StaticOrder, true, true>(F.lds + RING_OFF, g, S, E); SEAM(4); }
    if (IN(5)) { ln_phase(F, INP(I_XP), INP(I_XS), Y, INP(I_LMG), INP(I_LMB), XR, XR + (size_t)MP * D, XA); SEAM(5); }
    if (IN(6)) {
        pg8::Gemm g{XA, (const bf16*)(ws + WS_WUP0), M, FF2, D}; pg8::StaticOrder S; S.init(M, FF2, F.G, cblk); pg8::EpiUp E{H, out + O_FCP, out + O_FCS};
        pg8::gemm_phase<pg8::EpiUp, pg8::StaticOrder, true, true>(F.lds + RING_OFF, g, S, E); SEAM(6); }
    if (IN(7)) { convgate_phase(F, 0); SEAM(7); }
    if (IN(8)) {
        pg8::Gemm g{ACT, (const bf16*)(ws + WS_WDN0), M, D, FF}; pg8::StaticOrder S; S.init(M, D, F.G, cblk); pg8::EpiF32 E{Y, D};
        pg8::gemm_phase<pg8::EpiF32, pg8::StaticOrder, true, true>(F.lds + RING_OFF, g, S, E); SEAM(8); }
    if (IN(9)) { ln_phase(F, XR, XR + (size_t)MP * D, Y, INP(I_LFG), INP(I_LFB), XR, XR + (size_t)MP * D, XA); SEAM(9); }
    if (IN(10)) {
        pg8::Gemm g{XA, (const bf16*)(ws + WS_WINO), M, 2 * D, D}; pg8::StaticOrder S; S.init(M, 2 * D, F.G, cblk); pg8::EpiInO E{(bf16*)(ws + WS_U), (float*)(ws + WS_VR)};
        pg8::gemm_phase<pg8::EpiInO, pg8::StaticOrder, true, true>(F.lds + RING_OFF, g, S, E); SEAM(10); }
    if (IN(11)) { vln_phase(F); SEAM(11); }
    if (IN(12)) { sgu_phase(F); SEAM(12); }
    if (IN(13)) {
        pg8::Gemm g{(const bf16*)(ws + WS_G), (const bf16*)(ws + WS_WOUTO), M, D, D}; pg8::StaticOrder S; S.init(M, D, F.G, cblk); pg8::EpiF32 E{Y, D};
        pg8::gemm_phase<pg8::EpiF32, pg8::StaticOrder, true, true>(F.lds + RING_OFF, g, S, E); SEAM(13); }
    if (IN(14)) { ln_phase(F, XR, XR + (size_t)MP * D, Y, INP(I_LMG) + D, INP(I_LMB) + D, XR, XR + (size_t)MP * D, XA); SEAM(14); }
    if (IN(15)) {
        pg8::Gemm g{XA, (const bf16*)(ws + WS_WUP1), M, FF2, D}; pg8::StaticOrder S; S.init(M, FF2, F.G, cblk); pg8::EpiUp E{H, out + O_FCP + (size_t)NBP * 2 * FF2, out + O_FCS + (size_t)NBS * 2 * FF2};
        pg8::gemm_phase<pg8::EpiUp, pg8::StaticOrder, true, true>(F.lds + RING_OFF, g, S, E); SEAM(15); }
    if (IN(16)) { convgate_phase(F, 1); SEAM(16); }
    if (IN(17)) {
        pg8::Gemm g{ACT, (const bf16*)(ws + WS_WDN1), M, D, FF}; pg8::StaticOrder S; S.init(M, D, F.G, cblk); pg8::EpiF32 E{Y, D};
        pg8::gemm_phase<pg8::EpiF32, pg8::StaticOrder, true, true>(F.lds + RING_OFF, g, S, E); SEAM(17); }
    if (IN(18)) { ln_phase(F, XR, XR + (size_t)MP * D, Y, INP(I_LFG) + D, INP(I_LFB) + D, out + O_YP, out + O_YS, nullptr); }
#undef IN
#undef SEAM
}

extern "C" void kernel_launch(void* const* d_in, const int* in_sizes, int n_in, void* d_out, int out_size, void* d_ws, size_t ws_size, hipStream_t stream) {
    static int grid = 0;
    if (grid == 0) {
        if (n_in != N_IN || (size_t)out_size != O_END || ws_size < WS_END) { fprintf(stderr, "kernel_launch: built for %d inputs, %zu outputs, >= %zu bytes of workspace; got n_in %d, out %d, ws %zu; nothing launched\n", (int)N_IN, (size_t)O_END, (size_t)WS_END, n_in, out_size, ws_size); grid = -1; return; }
        int dev = 0, cus = 0, per_cu = 0;
        if (hipGetDevice(&dev) != hipSuccess || hipDeviceGetAttribute(&cus, hipDeviceAttributeMultiprocessorCount, dev) != hipSuccess) { fprintf(stderr, "kernel_launch: device query failed\n"); grid = -1; return; }
        if (hipFuncSetAttribute((const void*)fwd_kernel, hipFuncAttributeMaxDynamicSharedMemorySize, LDS_BYTES) != hipSuccess) { fprintf(stderr, "kernel_launch: hipFuncSetAttribute failed\n"); grid = -1; return; }
        if (hipOccupancyMaxActiveBlocksPerMultiprocessor(&per_cu, (const void*)fwd_kernel, NWAVES * 64, LDS_BYTES) != hipSuccess || per_cu < 1)
            fprintf(stderr, "kernel_launch: note: occupancy query reports %d workgroups per CU\n", per_cu);
        (void)hipGetLastError();
        grid = cus;
    }
    if (grid < 0) return;
    if (hipMemsetAsync((char*)d_ws + WS_CTL, 0, CTL_ZERO_BYTES, stream) != hipSuccess) { fprintf(stderr, "kernel_launch: hipMemsetAsync failed\n"); return; }
    Args a{};
    for (int i = 0; i < 32; ++i) a.in[i] = (const float*)d_in[i];
    a.out = (float*)d_out; a.ws = (unsigned char*)d_ws;
    for (int li = 0; li < N_LAUNCHES; ++li) {
        a.ph_lo = (N_LAUNCHES == PER_PHASE) ? li : 0; a.ph_hi = (N_LAUNCHES == PER_PHASE) ? li + 1 : PER_PHASE; a.li = li;
        hipLaunchKernelGGL(fwd_kernel, dim3(grid), dim3(NWAVES * 64), LDS_BYTES, stream, a);
        const hipError_t le = hipPeekAtLastError();
        if (le != hipSuccess) { fprintf(stderr, "kernel_launch: launch %d failed: %s\n", li, hipGetErrorName(le)); break; }
    }
}
```

```cpp
#include <hip/hip_runtime.h>
#include <cstdio>
#include <cstdint>
#include <cmath>
namespace pg8 {
#define PG8_LAS __attribute__((address_space(3)))
typedef unsigned short bf16_t;
typedef short bf16x8 __attribute__((ext_vector_type(8)));
typedef float f32x4 __attribute__((ext_vector_type(4)));
typedef unsigned u32x4 __attribute__((ext_vector_type(4)));
constexpr int BM = 256, BK = 64, HALF = 128, HTB = HALF * BK * 2  , STAGE_BYTES = 8 * HTB, NXCD = 8, WGM = 8;

__host__ __device__ __forceinline__ int lds_byte(int r, int c) { const int st = (r >> 4) * 2 + (c >> 5), rr = r & 15, cc = c & 31, ob = rr * 64 + cc * 2; return st * 1024 + (ob ^ (((ob >> 9) & 1) << 5)); }
__host__ __device__ __forceinline__ void stage_rc(int b, int& R, int& C) { const int st = b / 1024, sb = b % 1024, swz = sb ^ (((sb >> 9) & 1) << 5); R = (st >> 1) * 16 + swz / 64; C = (st & 1) * 32 + (swz % 64) / 2; }
__host__ __device__ __forceinline__ int perm32(int rho) { const int n = rho >> 4, i = rho & 15; return 8 * (i >> 2) + 4 * n + (i & 3); }

struct Unit { int pm, pn; };
struct Gemm { const bf16_t* A; const bf16_t* Bt; int M, N, K; int a_step_rows = 256; };

struct StaticOrder {
    int nM, nN, nwg, G, c, wgm;
    __host__ __device__ void init(int M, int N, int G_, int c_, int wgm_ = WGM) { nM = M / BM; nN = N / BM; nwg = nM * nN; G = G_; c = c_; wgm = wgm_; }
    __host__ __device__ bool next(int i, Unit& u) const {
        const long L = (long)i * G + c; if (L >= nwg) return false;
        int wgid = (int)L; { const int q = nwg / NXCD, r = nwg % NXCD, xcd = wgid % NXCD, off = wgid / NXCD; wgid = (xcd < r ? xcd * (q + 1) : r * (q + 1) + (xcd - r) * q) + off; }
        const int nig = wgm * nN, gid = wgid / nig, fm = gid * wgm, gsz = (nM - fm) < wgm ? (nM - fm) : wgm;
        u.pm = fm + ((wgid % nig) % gsz); u.pn = (wgid % nig) / gsz; return true;
    }
    __device__ __forceinline__ void a_ready(const Unit&) const {}
    __device__ __forceinline__ void done(const Unit&) const {}
};
__device__ __forceinline__ unsigned cvt_pk_bf16(float lo, float hi) { unsigned r; asm volatile("v_cvt_pk_bf16_f32 %0, %1, %2" : "=v"(r) : "v"(lo), "v"(hi)); return r; }
typedef float f32x2 __attribute__((ext_vector_type(2)));
__device__ __forceinline__ float gelu_tanh(float x) {
    const float y = x * (1.0f + 0.044715f * x * x);
    const float e = __builtin_amdgcn_exp2f(-2.302208198f * y);
    return x * __builtin_amdgcn_rcpf(1.0f + e);
}
__device__ __forceinline__ void st_bf16x8(bf16_t* p, f32x4 v0, f32x4 v1) {
    u32x4 w; w.x = cvt_pk_bf16(v0[0], v0[1]); w.y = cvt_pk_bf16(v0[2], v0[3]); w.z = cvt_pk_bf16(v1[0], v1[1]); w.w = cvt_pk_bf16(v1[2], v1[3]); *(u32x4*)p = w;
}
__device__ __forceinline__ void st_f32x8(float* p, f32x4 v0, f32x4 v1) { *(f32x4*)p = v0; *(f32x4*)(p + 4) = v1; }
__device__ __forceinline__ void st_f32x8_nt(float* p, f32x4 v0, f32x4 v1) { __builtin_nontemporal_store(v0, (f32x4*)p); __builtin_nontemporal_store(v1, (f32x4*)(p + 4)); }
__device__ __forceinline__ f32x2 gelu_tanh2(f32x2 v) {
    const f32x2 p = (v * v) * 0.044715f + 1.0f; const f32x2 a = (v * p) * (-2.302208198f);
    f32x2 ex; ex.x = __builtin_amdgcn_exp2f(a.x); ex.y = __builtin_amdgcn_exp2f(a.y);
    const f32x2 d = ex + 1.0f; f32x2 r; r.x = __builtin_amdgcn_rcpf(d.x); r.y = __builtin_amdgcn_rcpf(d.y);
    return v * r;
}
__device__ __forceinline__ f32x4 gelu4(f32x4 v) { const f32x2 a = gelu_tanh2((f32x2){v[0], v[1]}), b = gelu_tanh2((f32x2){v[2], v[3]}); return (f32x4){a.x, a.y, b.x, b.y}; }

constexpr int E_MP = 16384;

struct EpiInE {
    static constexpr bool PERM = true, AFTER_DRAIN = false;
    bf16_t *Q, *K, *V, *XB, *GB;
    float *okp, *ovp, *oks, *ovs, *orcp, *orcs;
    float qscale;
    __device__ __forceinline__ void operator()(const f32x4 (&acc)[2][2][4][2], const Unit& u, int wr, int wc, int fr, int fq) const {
        const int seg = u.pn >> 1; const int cb0 = (u.pn & 1) * 256 + wc * 32 + 8 * fq; const bool prm = u.pm < 64;
#pragma unroll
        for (int ai = 0; ai < 2; ++ai)
#pragma unroll
            for (int m = 0; m < 4; ++m) { const int row = u.pm * BM + ai * HALF + wr * 64 + m * 16 + fr;
#pragma unroll
                for (int bj = 0; bj < 2; ++bj) { const int c = cb0 + bj * HALF; const f32x4 v0 = acc[ai][bj][m][0], v1 = acc[ai][bj][m][1]; const size_t o = (size_t)row * 512 + c;
                    if (seg == 0) { st_bf16x8(Q + o, v0 * qscale, v1 * qscale); }
                    else if (seg == 1) { st_bf16x8(K + o, v0, v1); st_f32x8_nt(prm ? okp + o : oks + (o - (size_t)E_MP * 512), v0, v1); }
                    else if (seg == 2) { st_bf16x8(V + o, v0, v1); st_f32x8_nt(prm ? ovp + o : ovs + (o - (size_t)E_MP * 512), v0, v1); }
                    else if (seg == 3) { st_bf16x8(XB + o, v0, v1);
                        if (prm) { const int t = row & 4095; if (t >= 4093) st_f32x8(orcp + ((size_t)(row >> 12) * 3 + (t - 4093)) * 512 + c, v0, v1); }
                        else { const int rs = row - E_MP, t = rs & 63; if (t >= 61) st_f32x8(orcs + ((size_t)(rs >> 6) * 3 + (t - 61)) * 512 + c, v0, v1); } }
                    else { st_bf16x8(GB + o, gelu4(v0), gelu4(v1)); } } }
    }
};
__device__ __forceinline__ void row_stats(const float* st, int row, float& mu, float& rstd) {
    const f32x2 sq = *(const f32x2*)(st + 2 * (size_t)row); const float s = sq.x, q = sq.y;
    mu = s * (1.0f / 1024.0f); const float var = fmaxf(q * (1.0f / 1024.0f) - mu * mu, 0.f); rstd = 1.0f / sqrtf(var + 1e-5f);
}
__device__ __forceinline__ f32x4 bf16lo4(unsigned a, unsigned b) { return (f32x4){__builtin_bit_cast(float, a << 16), __builtin_bit_cast(float, a & 0xffff0000u), __builtin_bit_cast(float, b << 16), __builtin_bit_cast(float, b & 0xffff0000u)}; }
template <int MODE, bool OUT32> struct EpiRes {
    static constexpr bool PERM = true, AFTER_DRAIN = false;
    const float *xp, *xs;
    bf16_t* ZA; float* Z32;
    const float* st_in; const PG8_LAS float* gb_lds;
    float* st_out;
    __device__ __forceinline__ void operator()(const f32x4 (&acc)[2][2][4][2], const Unit& u, int wr, int wc, int fr, int fq) const {
        const int c0 = u.pn * BM + wc * 32 + 8 * fq; const float alpha = 1.41421356237309505f;
        constexpr int NB = MODE == 0 ? 2 : 4;
#pragma unroll
        for (int ai = 0; ai < 2; ++ai)
#pragma unroll
        for (int mh = 0; mh < 4 / NB; ++mh) {
            f32x4 rf[MODE == 0 ? NB : 1][2][2]; u32x4 rb[MODE != 0 ? NB : 1][2]; f32x2 sq[NB];
#pragma unroll
            for (int mm = 0; mm < NB; ++mm) { const int m = NB * mh + mm; const int row = u.pm * BM + ai * HALF + wr * 64 + m * 16 + fr;
                if (MODE == 1) sq[mm] = *(const f32x2*)(st_in + 2 * (size_t)row);
#pragma unroll
                for (int bj = 0; bj < 2; ++bj) { const size_t o = (size_t)row * 1024 + c0 + bj * HALF;
                    if (MODE == 0) { const float* src = row < E_MP ? xp + o : xs + (o - (size_t)E_MP * 1024); rf[mm][bj][0] = *(const f32x4*)src; rf[mm][bj][1] = *(const f32x4*)(src + 4); }
                    else rb[mm][bj] = *(const u32x4*)(ZA + o); } }
            asm volatile("" ::: "memory");
            float ss[NB], qq[NB];
#pragma unroll
            for (int mm = 0; mm < NB; ++mm) { const int m = NB * mh + mm; const int row = u.pm * BM + ai * HALF + wr * 64 + m * 16 + fr;
                float mu = 0.f, rstd = 1.f; if (MODE == 1) { mu = sq[mm].x * (1.0f / 1024.0f); const float var = fmaxf(sq[mm].y * (1.0f / 1024.0f) - mu * mu, 0.f); rstd = 1.0f / sqrtf(var + 1e-5f); }
                float s = 0.f, q = 0.f;
#pragma unroll
                for (int bj = 0; bj < 2; ++bj) { const size_t o = (size_t)row * 1024 + c0 + bj * HALF; f32x4 r0, r1;
                    if (MODE == 0) { r0 = rf[mm][bj][0]; r1 = rf[mm][bj][1]; }
                    else if (MODE == 2) { r0 = bf16lo4(rb[mm][bj].x, rb[mm][bj].y); r1 = bf16lo4(rb[mm][bj].z, rb[mm][bj].w); }
                    else { const PG8_LAS f32x4* gp = (const PG8_LAS f32x4*)(gb_lds + c0 + bj * HALF); const PG8_LAS f32x4* bp = (const PG8_LAS f32x4*)(gb_lds + 1024 + c0 + bj * HALF);
                        r0 = (bf16lo4(rb[mm][bj].x, rb[mm][bj].y) - mu) * rstd * gp[0] + bp[0]; r1 = (bf16lo4(rb[mm][bj].z, rb[mm][bj].w) - mu) * rstd * gp[1] + bp[1]; }
                    const f32x4 z0 = r0 * alpha + acc[ai][bj][m][0], z1 = r1 * alpha + acc[ai][bj][m][1];
                    if (OUT32) st_f32x8(Z32 + o, z0, z1); else st_bf16x8(ZA + o, z0, z1);
                    s += (z0[0] + z0[1]) + (z0[2] + z0[3]) + (z1[0] + z1[1]) + (z1[2] + z1[3]);
                    q += (z0[0] * z0[0] + z0[1] * z0[1]) + (z0[2] * z0[2] + z0[3] * z0[3]) + (z1[0] * z1[0] + z1[1] * z1[1]) + (z1[2] * z1[2] + z1[3] * z1[3]); }
                s += __shfl_xor(s, 16); s += __shfl_xor(s, 32); q += __shfl_xor(q, 16); q += __shfl_xor(q, 32); ss[mm] = s; qq[mm] = q; }
            asm volatile("" ::: "memory");
            if (st_out && fq == 0) {
#pragma unroll
                for (int mm = 0; mm < NB; ++mm) { const size_t row = (size_t)(u.pm * BM + ai * HALF + wr * 64 + (NB * mh + mm) * 16 + fr); atomicAdd(st_out + 2 * row, ss[mm]); atomicAdd(st_out + 2 * row + 1, qq[mm]); } }
            asm volatile("" ::: "memory");
        }
    }
};
__device__ __forceinline__ float dpp_ror1(float x) { return __builtin_bit_cast(float, __builtin_amdgcn_update_dpp(0, __builtin_bit_cast(int, x), 0x121, 0xF, 0xF, false)); }
__device__ __forceinline__ float dpp_ror2(float x) { return __builtin_bit_cast(float, __builtin_amdgcn_update_dpp(0, __builtin_bit_cast(int, x), 0x122, 0xF, 0xF, false)); }
constexpr int E_M = 18432, E_FF = 2816, E_FF2 = 5632;
struct EpiUpGate {
    static constexpr bool PERM = true, AFTER_DRAIN = false;
    bf16_t* ACT; float *ofcp, *ofcs;
    const float *st, *G, *B;
    const float *cw, *cb, *sfc;
    PG8_LAS float* xch;
    __device__ __forceinline__ void operator()(f32x4 (&acc)[2][2][4][2], const Unit& u, int wr, int wc, int fr, int fq) const {
        const int lc0 = wc * 32 + 8 * fq;
        const int R0 = 254 * u.pm - 2 + wr * 64 + fr;
        { f32x4 gq[2][2], bq[2][2];
#pragma unroll
          for (int bj = 0; bj < 2; ++bj)
#pragma unroll
              for (int n = 0; n < 2; ++n) { gq[bj][n] = *(const f32x4*)(G + u.pn * BM + bj * HALF + lc0 + 4 * n); bq[bj][n] = *(const f32x4*)(B + u.pn * BM + bj * HALF + lc0 + 4 * n); }
          f32x2 sq[2][4];
#pragma unroll
          for (int ai = 0; ai < 2; ++ai)
#pragma unroll
              for (int m = 0; m < 4; ++m) { int R = R0 + ai * HALF + m * 16; R = R < 0 ? 0 : (R >= E_M ? E_M - 1 : R); sq[ai][m] = *(const f32x2*)(st + 2 * (size_t)R); }
          asm volatile("" ::: "memory");
#pragma unroll
          for (int ai = 0; ai < 2; ++ai)
#pragma unroll
              for (int m = 0; m < 4; ++m) { const float mu = sq[ai][m].x * (1.0f / 1024.0f); const float rstd = 1.0f / sqrtf(fmaxf(sq[ai][m].y * (1.0f / 1024.0f) - mu * mu, 0.f) + 1e-5f);
#pragma unroll
                  for (int bj = 0; bj < 2; ++bj)
#pragma unroll
                      for (int n = 0; n < 2; ++n) acc[ai][bj][m][n] = (acc[ai][bj][m][n] - mu * gq[bj][n]) * rstd + bq[bj][n]; } }
#pragma unroll
        for (int ai = 0; ai < 2; ++ai)
#pragma unroll
            for (int m = 0; m < 4; ++m) { const int lr = ai * HALF + wr * 64 + m * 16 + fr, R = R0 + ai * HALF + m * 16;
                if (lr >= 2 && R < E_M) { float* dst = nullptr;
                    if (R < E_MP) { const int t = R & 4095; if (t >= 4094) dst = ofcp + ((size_t)(R >> 12) * 2 + (t - 4094)) * E_FF2; }
                    else { const int rs = R - E_MP, t = rs & 63; if (t >= 62) dst = ofcs + ((size_t)(rs >> 6) * 2 + (t - 62)) * E_FF2; }
                    if (dst) {
#pragma unroll
                        for (int bj = 0; bj < 2; ++bj) st_f32x8(dst + bj * E_FF + 128 * u.pn + lc0, acc[ai][bj][m][0], acc[ai][bj][m][1]); } } }
        if (fr >= 14) {
#pragma unroll
            for (int ai = 0; ai < 2; ++ai)
#pragma unroll
                for (int bj = 0; bj < 2; ++bj)
#pragma unroll
                    for (int n = 0; n < 2; ++n) *(PG8_LAS f32x4*)(xch + (((2 * ai + wr) * 2 + (fr - 14)) * 2 + bj) * 128 + lc0 + 4 * n) = acc[ai][bj][3][n]; }
        asm volatile("s_waitcnt lgkmcnt(0)" ::: "memory"); __builtin_amdgcn_s_barrier(); asm volatile("" ::: "memory");
        const int Rt0 = 254 * u.pm - 2, Rt1 = Rt0 + 255; const bool tile_has_start = Rt1 >= E_MP || ((Rt0 <= 0 ? 0 : ((Rt0 + 4095) & ~4095)) <= Rt1) || (((Rt0 <= 1 ? 1 : (((Rt0 - 1 + 4095) & ~4095) + 1))) <= Rt1);
        unsigned outp[2][4][2][2];
#pragma unroll
        for (int n = 0; n < 2; ++n) {
            const int gc = 128 * u.pn + lc0 + 4 * n;
            f32x4 w0[2], w1[2], w2[2], cbv[2];
#pragma unroll
            for (int bj = 0; bj < 2; ++bj) { w0[bj] = *(const f32x4*)(cw + gc + bj * E_FF); w1[bj] = *(const f32x4*)(cw + E_FF2 + gc + bj * E_FF); w2[bj] = *(const f32x4*)(cw + 2 * E_FF2 + gc + bj * E_FF); cbv[bj] = *(const f32x4*)(cb + gc + bj * E_FF); }
#pragma unroll
            for (int ai = 0; ai < 2; ++ai)
#pragma unroll
                for (int m = 0; m < 4; ++m) { const int R = R0 + ai * HALF + m * 16; const int blk = 2 * ai + wr;
                    int t; bool samp; if (R < E_MP) { t = R & 4095; samp = false; } else { t = (R - E_MP) & 63; samp = true; }
                    f32x4 y[2];
#pragma unroll
                    for (int bj = 0; bj < 2; ++bj) { const f32x4 cur = acc[ai][bj][m][n]; f32x4 prev;
                        if (m > 0) prev = acc[ai][bj][m - 1][n];
                        else if (blk > 0) prev = *(const PG8_LAS f32x4*)(xch + (((blk - 1) * 2 + (fr & 1)) * 2 + bj) * 128 + lc0 + 4 * n);
                        else prev = (f32x4){0.f, 0.f, 0.f, 0.f};
                        f32x4 p1, p2;
#pragma unroll
                        for (int e_ = 0; e_ < 4; ++e_) { p1[e_] = dpp_ror1(fr == 15 ? prev[e_] : cur[e_]); p2[e_] = dpp_ror2(fr >= 14 ? prev[e_] : cur[e_]); }
                        if (tile_has_start && t < 2 && R >= 0 && R < E_M) {
                            f32x4 s0 = {0.f, 0.f, 0.f, 0.f}, s1 = {0.f, 0.f, 0.f, 0.f};
                            if (samp) { const float* sp = sfc + (size_t)((R - E_MP) >> 6) * 2 * E_FF2 + gc + bj * E_FF; s0 = *(const f32x4*)sp; s1 = *(const f32x4*)(sp + E_FF2); }
                            if (t == 0) { p1 = s1; p2 = s0; } else p2 = s1; }
                        y[bj] = cbv[bj] + w0[bj] * p2 + w1[bj] * p1 + w2[bj] * cur; }
                    const f32x4 gte = gelu4(y[0]) * y[1];
                    outp[ai][m][n][0] = cvt_pk_bf16(gte[0], gte[1]); outp[ai][m][n][1] = cvt_pk_bf16(gte[2], gte[3]); }
        }
#pragma unroll
        for (int ai = 0; ai < 2; ++ai)
#pragma unroll
            for (int m = 0; m < 4; ++m) { const int lr = ai * HALF + wr * 64 + m * 16 + fr, R = R0 + ai * HALF + m * 16;
                if (lr >= 2 && R < E_M) { u32x4 w; w.x = outp[ai][m][0][0]; w.y = outp[ai][m][0][1]; w.z = outp[ai][m][1][0]; w.w = outp[ai][m][1][1]; *(u32x4*)(ACT + (size_t)R * E_FF + 128 * u.pn + lc0) = w; } }
    }
};
struct EpiInO {
    static constexpr bool PERM = true, AFTER_DRAIN = false;
    bf16_t* U; bf16_t* VB; const float *st, *G, *B; float* stv;
    __device__ __forceinline__ void operator()(const f32x4 (&acc)[2][2][4][2], const Unit& u, int wr, int wc, int fr, int fq) const {
        const bool isu = u.pn < 4; const int c0 = (u.pn & 3) * BM + wc * 32 + 8 * fq; const int cg0 = u.pn * BM + wc * 32 + 8 * fq;
        f32x4 gq[2][2], bq[2][2];
#pragma unroll
        for (int bj = 0; bj < 2; ++bj)
#pragma unroll
            for (int n = 0; n < 2; ++n) { gq[bj][n] = *(const f32x4*)(G + cg0 + bj * HALF + 4 * n); bq[bj][n] = *(const f32x4*)(B + cg0 + bj * HALF + 4 * n); }
        f32x2 sqa[2][4];
#pragma unroll
        for (int ai = 0; ai < 2; ++ai)
#pragma unroll
            for (int m = 0; m < 4; ++m) sqa[ai][m] = *(const f32x2*)(st + 2 * (size_t)(u.pm * BM + ai * HALF + wr * 64 + m * 16 + fr));
        asm volatile("" ::: "memory");
#pragma unroll
        for (int ai = 0; ai < 2; ++ai) {
            const f32x2 (&sq)[4] = sqa[ai];
            float ss[4], qq[4];
#pragma unroll
            for (int m = 0; m < 4; ++m) { const int row = u.pm * BM + ai * HALF + wr * 64 + m * 16 + fr;
                const float mu = sq[m].x * (1.0f / 1024.0f); const float rstd = 1.0f / sqrtf(fmaxf(sq[m].y * (1.0f / 1024.0f) - mu * mu, 0.f) + 1e-5f);
                float s = 0.f, q = 0.f;
#pragma unroll
                for (int bj = 0; bj < 2; ++bj) { const size_t o = (size_t)row * 1024 + c0 + bj * HALF;
                    const f32x4 v0 = gelu4((acc[ai][bj][m][0] - mu * gq[bj][0]) * rstd + bq[bj][0]), v1 = gelu4((acc[ai][bj][m][1] - mu * gq[bj][1]) * rstd + bq[bj][1]);
                    st_bf16x8((isu ? U : VB) + o, v0, v1);
                    s += (v0[0] + v0[1]) + (v0[2] + v0[3]) + (v1[0] + v1[1]) + (v1[2] + v1[3]);
                    q += (v0[0] * v0[0] + v0[1] * v0[1]) + (v0[2] * v0[2] + v0[3] * v0[3]) + (v1[0] * v1[0] + v1[1] * v1[1]) + (v1[2] * v1[2] + v1[3] * v1[3]); }
                s += __shfl_xor(s, 16); s += __shfl_xor(s, 32); q += __shfl_xor(q, 16); q += __shfl_xor(q, 32); ss[m] = s; qq[m] = q; }
            asm volatile("" ::: "memory");
            if (!isu && fq == 0) {
#pragma unroll
                for (int m = 0; m < 4; ++m) { const size_t row = (size_t)(u.pm * BM + ai * HALF + wr * 64 + m * 16 + fr); atomicAdd(stv + 2 * row, ss[m]); atomicAdd(stv + 2 * row + 1, qq[m]); } }
            asm volatile("" ::: "memory");
        }
    }
};
template <class Epi, class Sched, bool ALIGN_EPI = false, bool SP2 = false>
__device__ __forceinline__ void gemm_phase(PG8_LAS unsigned char* lds, const Gemm g, const Sched& S, const Epi& E, const int wave_id) {
    int lane; asm volatile("v_mbcnt_lo_u32_b32 %0, -1, 0\n\tv_mbcnt_hi_u32_b32 %0, -1, %0" : "=v"(lane)); const int wid = wave_id, tid = wid * 64 + lane, wr = wid >> 2, wc = wid & 3, fr = lane & 15, fq = lane >> 4;
    const int K = g.K, nt = K / BK;
    unsigned voffA[2], voffB[2];
#pragma unroll
    for (int i = 0; i < 2; ++i) { int R, C; stage_rc(tid * 16 + i * 8192, R, C); const int Rb = Epi::PERM ? ((R & ~31) + perm32(R & 31)) : R;
        voffA[i] = (unsigned)(R * K + C) * 2u; voffB[i] = (unsigned)(Rb * K + C) * 2u; }
    const size_t kstep = (size_t)(BK * 2);
    const size_t hstep = (size_t)HALF * K * 2;
    const size_t tstep = 2 * hstep;
    const size_t tstepA = (size_t)g.a_step_rows * K * 2;
    const unsigned ldsw = (unsigned)wid * 1024u;
    const int aoff = lds_byte(wr * 64 + fr, fq * 8), boff = lds_byte(wc * 32 + fr, fq * 8);
#define PG8_SA(b, h) (((b) * 2 + (h)) * HTB)
#define PG8_SB(b, h) ((4 + (b) * 2 + (h)) * HTB)
#define PG8_STAGE(bufoff, gbase, voff) do { _Pragma("unroll") for (int _i = 0; _i < 2; ++_i) \
        __builtin_amdgcn_global_load_lds((const unsigned*)((const char*)(gbase) + (voff)[_i]), (PG8_LAS unsigned*)(lds + (bufoff) + ldsw + _i * 8192), 16, 0, 0); } while (0)
#define PG8_LDA(dst, b, h) do { _Pragma("unroll") for (int m = 0; m < 4; ++m) _Pragma("unroll") for (int k = 0; k < 2; ++k) dst[m][k] = *(const PG8_LAS bf16x8*)(lds + PG8_SA(b, h) + aoff + m * 2048 + k * 1024); } while (0)
#define PG8_LDB(dst, b, h) do { _Pragma("unroll") for (int n = 0; n < 2; ++n) _Pragma("unroll") for (int k = 0; k < 2; ++k) dst[n][k] = *(const PG8_LAS bf16x8*)(lds + PG8_SB(b, h) + boff + n * 2048 + k * 1024); } while (0)
#define PG8_MMA(ai, bj, At, Bt) do { __builtin_amdgcn_s_setprio(1); _Pragma("unroll") for (int m = 0; m < 4; ++m) _Pragma("unroll") for (int n = 0; n < 2; ++n) _Pragma("unroll") for (int k = 0; k < 2; ++k) \
        acc[ai][bj][m][n] = __builtin_amdgcn_mfma_f32_16x16x32_bf16(Bt[n][k], At[m][k], acc[ai][bj][m][n], 0, 0, 0); __builtin_amdgcn_s_setprio(0); } while (0)
#define PG8_WAIT_V(n) asm volatile("s_waitcnt vmcnt(" #n ")" ::: "memory")
#define PG8_WAIT_L(n) asm volatile("s_waitcnt lgkmcnt(" #n ")" ::: "memory")
#define PG8_BAR __builtin_amdgcn_s_barrier()
#define PG8_SCHED __builtin_amdgcn_sched_barrier(0)
    Unit cur, nxt; int ui = 0;
    if (!S.next(0, cur)) return;
    f32x4 acc[2][2][4][2];
#pragma unroll
    for (int a = 0; a < 2; ++a)
#pragma unroll
        for (int b = 0; b < 2; ++b)
#pragma unroll
            for (int m = 0; m < 4; ++m)
#pragma unroll
                for (int n = 0; n < 2; ++n) acc[a][b][m][n] = (f32x4){0.f, 0.f, 0.f, 0.f};
    bf16x8 At[4][2], B0[2][2], B1[2][2];
    const char* cA = (const char*)g.A + (size_t)cur.pm * tstepA; const char* cB = (const char*)g.Bt + (size_t)cur.pn * tstep;
    S.a_ready(cur);
    if constexpr (SP2) {
        PG8_STAGE(PG8_SB(0, 0), cB, voffB); PG8_STAGE(PG8_SB(0, 1), cB + hstep, voffB); PG8_STAGE(PG8_SA(0, 0), cA, voffA); PG8_STAGE(PG8_SA(0, 1), cA + hstep, voffA);
        if (wr == 1) PG8_BAR;
        PG8_WAIT_V(2); PG8_BAR;
        PG8_STAGE(PG8_SB(1, 0), cB + kstep, voffB); PG8_STAGE(PG8_SA(1, 0), cA + kstep, voffA); PG8_STAGE(PG8_SB(1, 1), cB + hstep + kstep, voffB);
        PG8_WAIT_V(6); PG8_BAR;
    } else {
        PG8_STAGE(PG8_SB(0, 0), cB, voffB); PG8_STAGE(PG8_SA(0, 0), cA, voffA); PG8_STAGE(PG8_SB(0, 1), cB + hstep, voffB); PG8_STAGE(PG8_SA(0, 1), cA + hstep, voffA);
        if (wr == 1) PG8_BAR;
        PG8_WAIT_V(4); PG8_BAR;
        PG8_STAGE(PG8_SB(1, 0), cB + kstep, voffB); PG8_STAGE(PG8_SA(1, 0), cA + kstep, voffA); PG8_STAGE(PG8_SB(1, 1), cB + hstep + kstep, voffB);
        PG8_WAIT_V(6); PG8_BAR;
    }
    for (;;) {
        const bool has_next = S.next(ui + 1, nxt);
        const char* nA = has_next ? (const char*)g.A + (size_t)nxt.pm * tstepA : cA; const char* nB = has_next ? (const char*)g.Bt + (size_t)nxt.pn * tstep : cB;
        for (int t = 0; t < nt; t += 2) {
            const bool last = (t == nt - 2);
            const char* a1 = cA + (size_t)(t + 1) * kstep;
            const char* a2 = last ? nA : cA + (size_t)(t + 2) * kstep; const char* b2 = last ? nB : cB + (size_t)(t + 2) * kstep;
            const char* a3 = a2 + kstep; const char* b3 = b2 + kstep;
            if (last && has_next) S.a_ready(nxt);
            if constexpr (SP2) {
            PG8_LDB(B0, 0, 0); PG8_LDB(B1, 0, 1); PG8_SCHED; PG8_LDA(At, 0, 0); PG8_STAGE(PG8_SA(1, 1), a1 + hstep, voffA);
            PG8_WAIT_V(8); PG8_WAIT_L(0); PG8_BAR; PG8_MMA(0, 0, At, B0); PG8_MMA(0, 1, At, B1); PG8_BAR; PG8_SCHED;
            PG8_LDA(At, 0, 1); PG8_STAGE(PG8_SB(0, 0), b2, voffB); PG8_STAGE(PG8_SB(0, 1), b2 + hstep, voffB); PG8_STAGE(PG8_SA(0, 0), a2, voffA);
            PG8_WAIT_V(8); PG8_WAIT_L(0); PG8_BAR; PG8_MMA(1, 0, At, B0); PG8_MMA(1, 1, At, B1); PG8_BAR; PG8_SCHED;
            PG8_LDB(B0, 1, 0); PG8_LDB(B1, 1, 1); PG8_SCHED; PG8_LDA(At, 1, 0); PG8_STAGE(PG8_SA(0, 1), a2 + hstep, voffA);
            PG8_WAIT_V(8); PG8_WAIT_L(0); PG8_BAR; PG8_MMA(0, 0, At, B0); PG8_MMA(0, 1, At, B1); PG8_BAR; PG8_SCHED;
            PG8_LDA(At, 1, 1); PG8_STAGE(PG8_SB(1, 0), b3, voffB); PG8_STAGE(PG8_SB(1, 1), b3 + hstep, voffB); PG8_STAGE(PG8_SA(1, 0), a3, voffA);
            PG8_WAIT_V(8); PG8_WAIT_L(0); PG8_BAR; PG8_MMA(1, 0, At, B0); PG8_MMA(1, 1, At, B1); PG8_BAR; PG8_SCHED;
            } else {
            PG8_LDB(B0, 0, 0); PG8_SCHED; PG8_LDA(At, 0, 0); PG8_STAGE(PG8_SA(1, 1), a1 + hstep, voffA);
            PG8_WAIT_L(8); PG8_BAR; PG8_WAIT_L(0); PG8_MMA(0, 0, At, B0); PG8_BAR; PG8_SCHED;
            PG8_LDB(B1, 0, 1); PG8_STAGE(PG8_SB(0, 0), b2, voffB);
            PG8_BAR; PG8_WAIT_L(0); PG8_MMA(0, 1, At, B1); PG8_BAR;
            PG8_LDA(At, 0, 1); PG8_STAGE(PG8_SA(0, 0), a2, voffA);
            PG8_BAR; PG8_WAIT_L(0); PG8_MMA(1, 0, At, B0); PG8_BAR; PG8_SCHED;
            PG8_STAGE(PG8_SB(0, 1), b2 + hstep, voffB);
            PG8_WAIT_V(6); PG8_BAR; PG8_MMA(1, 1, At, B1); PG8_BAR;
            PG8_LDB(B0, 1, 0); PG8_SCHED; PG8_LDA(At, 1, 0); PG8_STAGE(PG8_SA(0, 1), a2 + hstep, voffA);
            PG8_WAIT_L(8); PG8_BAR; PG8_WAIT_L(0); PG8_MMA(0, 0, At, B0); PG8_BAR; PG8_SCHED;
            PG8_LDB(B1, 1, 1); PG8_STAGE(PG8_SB(1, 0), b3, voffB);
            PG8_BAR; PG8_WAIT_L(0); PG8_MMA(0, 1, At, B1); PG8_BAR;
            PG8_LDA(At, 1, 1); PG8_STAGE(PG8_SA(1, 0), a3, voffA);
            PG8_BAR; PG8_WAIT_L(0); PG8_MMA(1, 0, At, B0); PG8_BAR; PG8_SCHED;
            PG8_STAGE(PG8_SB(1, 1), b3 + hstep, voffB);
            PG8_WAIT_V(6); PG8_BAR; PG8_MMA(1, 1, At, B1); PG8_BAR;
            }
        }
        if constexpr (ALIGN_EPI) { if (wr == 0) PG8_BAR; }
        if constexpr (!Epi::AFTER_DRAIN) { E(acc, cur, wr, wc, fr, fq); S.done(cur); }
        if (!has_next) break;
#pragma unroll
        for (int a = 0; a < 2; ++a)
#pragma unroll
            for (int b = 0; b < 2; ++b)
#pragma unroll
                for (int m = 0; m < 4; ++m)
#pragma unroll
                    for (int n = 0; n < 2; ++n) acc[a][b][m][n] = (f32x4){0.f, 0.f, 0.f, 0.f};
        cur = nxt; cA = nA; cB = nB; ++ui;
        if constexpr (ALIGN_EPI) { if (wr == 1) PG8_BAR; }
    }
    PG8_WAIT_V(0);
    if constexpr (!ALIGN_EPI) { if (wr == 0) PG8_BAR; }
    PG8_BAR;
    if constexpr (Epi::AFTER_DRAIN) { E.fused(acc, cur, wr, wc, fr, fq, lds, wid, lane); S.done(cur); }
#undef PG8_SA
#undef PG8_SB
#undef PG8_STAGE
#undef PG8_LDA
#undef PG8_LDB
#undef PG8_MMA
#undef PG8_WAIT_V
#undef PG8_WAIT_L
#undef PG8_BAR
#undef PG8_SCHED
}
}
#define GAS __attribute__((address_space(1)))
#define LAS __attribute__((address_space(3)))
typedef unsigned short bf16;
typedef unsigned v4u __attribute__((ext_vector_type(4)));
typedef float f32x4 __attribute__((ext_vector_type(4)));
typedef short bf16x8 __attribute__((ext_vector_type(8)));
typedef GAS unsigned gu32;
typedef GAS unsigned long long gu64;
#define RLX_AGENT __ATOMIC_RELAXED, __HIP_MEMORY_SCOPE_AGENT
#define LDS_WAIT() asm volatile("s_waitcnt lgkmcnt(0)" ::: "memory")
#define VM_WAIT() asm volatile("s_waitcnt vmcnt(0)" ::: "memory")
__device__ __forceinline__ unsigned long long rt() { return __builtin_amdgcn_s_memrealtime(); }
__device__ __forceinline__ unsigned f2bf(float f) { unsigned u = __builtin_bit_cast(unsigned, f); return (u + 0x7fffu + ((u >> 16) & 1u)) >> 16; }
__device__ __forceinline__ unsigned pk2(float lo, float hi) { return f2bf(lo) | (f2bf(hi) << 16); }

#define XB_TMO      128
#define XB_XCNT(j)  (256  + 64 * (j))
#define XB_XSUB(j)  (1280 + 64 * (j))
#define XB_XGEN(j)  (2304 + 64 * (j))
#define XB_TOP      3328
#define XB_TOPGEN   3392
#define XCD_BAR_WORDS 3456
#define XB_SPIN_CAP (1u << 18)

__device__ __forceinline__ unsigned xb_ld(unsigned* p)              { return __hip_atomic_load(p, __ATOMIC_RELAXED, __HIP_MEMORY_SCOPE_AGENT); }
__device__ __forceinline__ unsigned xb_add(unsigned* p, unsigned v) { return __hip_atomic_fetch_add(p, v, __ATOMIC_RELAXED, __HIP_MEMORY_SCOPE_AGENT); }
__device__ __forceinline__ unsigned xb_xcc_id() { return (unsigned)__builtin_amdgcn_s_getreg((3 << 11) | 20) & 0xFu; }
#define XB_SPIN(cond, bar) do { unsigned _sp = 0; while (cond) { __builtin_amdgcn_s_sleep(1); \
    if ((++_sp & 255u) == 0u) { if (xb_ld(&(bar)[XB_TMO])) break; if (_sp > XB_SPIN_CAP) { atomicAdd(&(bar)[XB_TMO], 1u); break; } } } } while (0)

struct XcdBarrier {
    unsigned* bar; unsigned x; int wave;
    volatile LAS unsigned* st;
};

__device__ __forceinline__ bool xb_lane0() { int r; asm volatile("v_mbcnt_lo_u32_b32 %0, -1, 0\n\tv_mbcnt_hi_u32_b32 %0, -1, %0" : "=v"(r)); return r == 0; }
#define XB_TID0(b) ((b).wave == 0 && xb_lane0())
__device__ __forceinline__ XcdBarrier xcd_barrier_post(unsigned* bar, volatile LAS unsigned* st, int wave) {
    XcdBarrier b; b.bar = bar; b.x = xb_xcc_id(); b.st = st; b.wave = wave;
    if (XB_TID0(b)) (void)xb_add(&bar[XB_XCNT(b.x)], 1u);
    return b;
}
__device__ __forceinline__ void xcd_barrier_complete(unsigned* bar, unsigned x, unsigned& nloc, unsigned& nx) {
    const unsigned G = gridDim.x * gridDim.y * gridDim.z;
    unsigned sum, cnt, mine, sp = 0u;
    for (;;) {
        sum = 0u; cnt = 0u; mine = 0u;
#pragma unroll
        for (unsigned j = 0; j < 16; ++j) { const unsigned c = xb_ld(&bar[XB_XCNT(j)]); sum += c; cnt += (c > 0u) ? 1u : 0u; mine = (j == x) ? c : mine; }
        if (sum == G) break;
        __builtin_amdgcn_s_sleep(1);
        if ((++sp & 255u) == 0u) { if (xb_ld(&bar[XB_TMO])) break; if (sp > XB_SPIN_CAP) { atomicAdd(&bar[XB_TMO], 1u); break; } }
    }
    nloc = mine > 0u ? mine : 1u; nx = cnt > 0u ? cnt : 1u;
}

__device__ __forceinline__ void xcd_barrier(const XcdBarrier& b) {
    asm volatile("s_waitcnt vmcnt(0)" ::: "memory");
    __syncthreads();
    if (XB_TID0(b)) {
        unsigned* bar = b.bar;
        __builtin_amdgcn_s_waitcnt(0);
        unsigned nloc = b.st[0], nx = b.st[1];
        if (nloc == 0u) { xcd_barrier_complete(bar, b.x, nloc, nx); b.st[0] = nloc; b.st[1] = nx; }
        const unsigned old = xb_add(&bar[XB_XSUB(b.x)], 1u);
        const unsigned gen = old / nloc;
        if (old + 1u == (gen + 1u) * nloc) {
            __builtin_amdgcn_fence(__ATOMIC_RELEASE, "agent");
            asm volatile("s_waitcnt vmcnt(0)" ::: "memory");
            const unsigned og = xb_add(&bar[XB_TOP], 1u);
            const unsigned tg = og / nx;
            if (og + 1u == (tg + 1u) * nx) xb_add(&bar[XB_TOPGEN], 1u);
            else XB_SPIN(xb_ld(&bar[XB_TOPGEN]) == tg, bar);
            __builtin_amdgcn_fence(__ATOMIC_ACQUIRE, "agent");
            xb_add(&bar[XB_XGEN(b.x)], 1u);
            asm volatile("s_waitcnt vmcnt(0)" ::: "memory");
        } else {
            XB_SPIN(xb_ld(&bar[XB_XGEN(b.x)]) == gen, bar);
            __builtin_amdgcn_fence(__ATOMIC_ACQUIRE, "agent");
            asm volatile("s_waitcnt vmcnt(0)" ::: "memory");
        }
    }
    __syncthreads();
}
constexpr int NWAVES = 8;
constexpr int D = 1024, TP = 4096, TS = 64, NBP = 4, NBS = 32, PAST = 2048;
constexpr int MP = NBP * TP, MS = NBS * TS, M = MP + MS;
constexpr int NH = 8, HDIM = 64, AW = 512, BW = 512, ECOLS = 2568, NE = 2560, FF = 2816, FF2 = 5632;
constexpr float ALPHA = 1.41421356237309505f, LN_EPS = 1e-5f, LOG2E = 1.4426950408889634f, QSCALE = 0.125f * 1.4426950408889634f;
static_assert(MP == pg8::E_MP, "prompt rows");
enum { I_XP = 0, I_XS, I_CK, I_CV, I_CLF, I_SRC, I_SRH, I_SFC, I_WINE, I_BF, I_RCW, I_RCB, I_RWA, I_RBA, I_RWX, I_RBX, I_RLAM, I_WOUTE, I_WINO, I_SGG, I_SGB, I_SGW, I_SGBIAS, I_WOUTO,
       I_LMG, I_LMB, I_LFG, I_LFB, I_WUP, I_FCW, I_FCB, I_WDN, N_IN };
constexpr size_t O_YP = 0, O_YS = O_YP + (size_t)MP * D, O_KP = O_YS + (size_t)MS * D, O_VP = O_KP + (size_t)MP * AW, O_LFP = O_VP + (size_t)MP * AW, O_KS = O_LFP + (size_t)MP * NH,
                 O_VS = O_KS + (size_t)MS * AW, O_LFS = O_VS + (size_t)MS * AW, O_RCP = O_LFS + (size_t)MS * NH, O_RHP = O_RCP + (size_t)NBP * 3 * BW, O_RCS = O_RHP + (size_t)NBP * BW,
                 O_RHS = O_RCS + (size_t)NBS * 3 * BW, O_FCP = O_RHS + (size_t)NBS * BW, O_FCS = O_FCP + (size_t)2 * NBP * 2 * FF2, O_SGV = O_FCS + (size_t)2 * NBS * 2 * FF2, O_END = O_SGV + (size_t)MS * D;
static_assert(O_END == 40878080, "output size");
constexpr size_t MiB = 1u << 20;
constexpr size_t WS_CTL = 0, CTL_ZERO_BYTES = 1 * MiB;
constexpr size_t WS_WINE = 2 * MiB, WS_WOUTE = 7 * MiB, WS_WINO = 9 * MiB, WS_WOUTO = 13 * MiB, WS_WUP0 = 15 * MiB, WS_WUP1 = 26 * MiB, WS_WDN0 = 37 * MiB, WS_WDN1 = WS_WDN0 + 5 * MiB + MiB / 2;
constexpr size_t WS_KBP = 48 * MiB, WS_KBS = WS_KBP + MiB / 2, WS_CARRY = 50 * MiB + 3 * (MiB / 4);
constexpr size_t WS_WAT = 52 * MiB - 2 * 65536, WS_WXT = 52 * MiB - 65536;
constexpr size_t WS_XA = 52 * MiB;
constexpr size_t WS_XR = 88 * MiB;
constexpr size_t WS_A = 160 * MiB;
constexpr size_t WS_Q = WS_A, WS_K = WS_A + 18 * MiB, WS_V = WS_A + 36 * MiB, WS_XB = WS_A + 54 * MiB, WS_GB = WS_A + 72 * MiB, WS_MIX = WS_A + 90 * MiB, WS_Y = WS_A + 126 * MiB;
constexpr size_t WS_H = WS_A;
constexpr size_t WS_U = WS_A, WS_VN = WS_A + 36 * MiB, WS_G = WS_A + 72 * MiB, WS_VR = WS_Y;
constexpr size_t WS_KC = WS_Y;
constexpr size_t WS_ACT = 358 * MiB, WS_VC = WS_ACT;
constexpr size_t WS_ACT_END = 457 * MiB;
constexpr size_t WS_PGB = 457 * MiB, WS_GBV = 459 * MiB, WS_END = 460 * MiB;
constexpr int NVEC = 2 * FF2 + 2 * D, VEC_UP0 = 0, VEC_UP1 = FF2, VEC_INO = 2 * FF2;
constexpr int CW_STAT = 32768;
static_assert(WS_WDN1 + (size_t)D * FF * 2 <= WS_KBP && WS_KBS + (size_t)256 * 2112 * 4 <= WS_CARRY && WS_CARRY + (size_t)2304 * 64 * 8 <= WS_WAT && WS_XA + (size_t)M * D * 2 == WS_XR && WS_XR + (size_t)M * D * 4 == WS_A, "ws map 1");
static_assert(WS_Y + (size_t)M * D * 4 == WS_ACT && WS_H + (size_t)M * FF2 * 2 == WS_ACT && WS_ACT + (size_t)M * FF * 2 == WS_ACT_END && WS_MIX + (size_t)M * D * 2 == WS_Y && WS_KC + (size_t)NBS * PAST * AW * 2 <= WS_ACT, "ws map 2");
static_assert((size_t)2 * 16 * NVEC * 4 <= 2 * MiB && (size_t)2 * NVEC * 4 <= MiB && ((size_t)CW_STAT + (size_t)4 * M * 2) * 4 <= CTL_ZERO_BYTES, "ws map 3");
constexpr int CW_TMO = 0, CW_CODE = 1, CW_BAR = 4096;
static_assert((CW_BAR + 3456) * 4 <= 32768, "the host memset (32 KiB) covers the barrier words");
constexpr int RING_OFF = 0, RING_BYTES = 131072, LDSCTL_OFF = RING_BYTES, MISC_OFF = LDSCTL_OFF + 320, LDS_BYTES = 147456;
struct Frame {
    LAS unsigned char* lds;
    volatile LAS unsigned* MISC;
    gu32* ctl;
    int wave;
    int vcu, G;
    float* out; unsigned char* ws;
};
typedef const float* cfptr_t;
__device__ __forceinline__ const float* inp_ptr(int i) { return ((const __attribute__((address_space(4))) cfptr_t*)__builtin_amdgcn_kernarg_segment_ptr())[i]; }
#define INP(i) inp_ptr(i)
__device__ __forceinline__ int flane() { int r; asm volatile("v_mbcnt_lo_u32_b32 %0, -1, 0\n\tv_mbcnt_hi_u32_b32 %0, -1, %0" : "=v"(r)); return r; }
__device__ __forceinline__ int ftid(const Frame& F) { return F.wave * 64 + flane(); }
__device__ __forceinline__ float bf2f(bf16 h) { return __builtin_bit_cast(float, (unsigned)h << 16); }
__device__ __forceinline__ float wave_sum(float v) {
#pragma unroll
    for (int o = 1; o < 64; o <<= 1) v += __shfl_xor(v, o);
    return v;
}
__device__ __forceinline__ void unpack8(v4u w, float (&v)[8]) {
    v[0] = __builtin_bit_cast(float, w.x << 16); v[1] = __builtin_bit_cast(float, w.x & 0xffff0000u); v[2] = __builtin_bit_cast(float, w.y << 16); v[3] = __builtin_bit_cast(float, w.y & 0xffff0000u);
    v[4] = __builtin_bit_cast(float, w.z << 16); v[5] = __builtin_bit_cast(float, w.z & 0xffff0000u); v[6] = __builtin_bit_cast(float, w.w << 16); v[7] = __builtin_bit_cast(float, w.w & 0xffff0000u);
}
__device__ __forceinline__ v4u pack8(const float (&v)[8]) { v4u o; o.x = pk2(v[0], v[1]); o.y = pk2(v[2], v[3]); o.z = pk2(v[4], v[5]); o.w = pk2(v[6], v[7]); return o; }
__device__ __forceinline__ float gelu_tanh_f(float x) { return pg8::gelu_tanh(x); }

__device__ __forceinline__ void tr_item(const float* W, int ldw, int K, bf16* WT, int src_col0, int dst_row0, int kb, LAS float* scr, int lane, const float* gsc = nullptr, const float* bsc = nullptr, float* PG = nullptr, float* PB = nullptr, int vec0 = 0) {
    const int k0 = 64 * kb;
#pragma unroll 8
    for (int i = 0; i < 32; ++i) { const int kk = 2 * i + (lane >> 5); scr[kk * 33 + (lane & 31)] = W[(size_t)(k0 + kk) * ldw + src_col0 + (lane & 31)]; }
    LDS_WAIT(); asm volatile("" ::: "memory");
    const int c = lane & 7;
    if (gsc) { float g8[8], b8[8];
#pragma unroll
        for (int i = 0; i < 8; ++i) { g8[i] = gsc[k0 + 8 * c + i]; b8[i] = bsc[k0 + 8 * c + i]; }
#pragma unroll
        for (int j = 0; j < 4; ++j) { const int n = (lane >> 3) + 8 * j; const LAS float* s = scr + (8 * c) * 33 + n; float w[8], pg = 0.f, pb = 0.f;
#pragma unroll
            for (int i = 0; i < 8; ++i) { w[i] = s[i * 33]; pb += b8[i] * w[i]; w[i] *= g8[i]; }
            v4u o; o.x = pk2(w[0], w[1]); o.y = pk2(w[2], w[3]); o.z = pk2(w[4], w[5]); o.w = pk2(w[6], w[7]);
            pg = (__builtin_bit_cast(float, o.x << 16) + __builtin_bit_cast(float, o.x & 0xffff0000u)) + (__builtin_bit_cast(float, o.y << 16) + __builtin_bit_cast(float, o.y & 0xffff0000u))
               + (__builtin_bit_cast(float, o.z << 16) + __builtin_bit_cast(float, o.z & 0xffff0000u)) + (__builtin_bit_cast(float, o.w << 16) + __builtin_bit_cast(float, o.w & 0xffff0000u));
            *(GAS v4u*)(WT + (size_t)(dst_row0 + n) * K + k0 + 8 * c) = o;
            pg += __shfl_xor(pg, 1); pg += __shfl_xor(pg, 2); pg += __shfl_xor(pg, 4); pb += __shfl_xor(pb, 1); pb += __shfl_xor(pb, 2); pb += __shfl_xor(pb, 4);
            if (c == 0) { PG[(size_t)kb * NVEC + vec0 + dst_row0 + n] = pg; PB[(size_t)kb * NVEC + vec0 + dst_row0 + n] = pb; } } }
    else {
#pragma unroll
    for (int j = 0; j < 4; ++j) { const int n = (lane >> 3) + 8 * j; const LAS float* s = scr + (8 * c) * 33 + n;
        v4u o; o.x = pk2(s[0 * 33], s[1 * 33]); o.y = pk2(s[2 * 33], s[3 * 33]); o.z = pk2(s[4 * 33], s[5 * 33]); o.w = pk2(s[6 * 33], s[7 * 33]);
        *(GAS v4u*)(WT + (size_t)(dst_row0 + n) * K + k0 + 8 * c) = o; } }
    LDS_WAIT(); asm volatile("" ::: "memory");
}
__device__ __forceinline__ float log_sigmoid_f(float z) { return z >= 0.f ? -log1pf(expf(-z)) : z - log1pf(expf(z)); }
__device__ __forceinline__ void weights_set(Frame& F, int set, int gw, int NGW) {
    LAS float* scr = (LAS float*)(F.lds + RING_OFF + F.wave * 16384); const int lane = flane();
    unsigned char* ws = F.ws; float* PG = (float*)(ws + WS_PGB); float* PB = PG + 16 * NVEC;
    constexpr int I0 = 16 * 80, I1 = 16 * 32, I2 = 16 * 64, I3 = 16 * 32, I4 = 16 * 176, I5 = I4, I6 = 44 * 32, I7 = I6;
    if (set == 0) for (int it = gw; it < I0 + I1 + I4 + I6; it += NGW) { int r = it;
        if (r < I0) { const int kb = r / 80, nb = r % 80; const int dst = 32 * nb, src = dst < 1536 ? dst : dst + 8; tr_item(INP(I_WINE), ECOLS, D, (bf16*)(ws + WS_WINE), src, dst, kb, scr, lane); continue; } r -= I0;
        if (r < I1) { tr_item(INP(I_WOUTE), D, D, (bf16*)(ws + WS_WOUTE), 32 * (r % 32), 32 * (r % 32), r / 32, scr, lane); continue; } r -= I1;
        if (r < I4) { const int sc = 32 * (r % 176); const int dr = sc < FF ? 256 * (sc / 128) + sc % 128 : 256 * ((sc - FF) / 128) + 128 + (sc - FF) % 128; tr_item(INP(I_WUP), FF2, D, (bf16*)(ws + WS_WUP0), sc, dr, r / 176, scr, lane, INP(I_LMG), INP(I_LMB), PG, PB, VEC_UP0); continue; } r -= I4;
        tr_item(INP(I_WDN), D, FF, (bf16*)(ws + WS_WDN0), 32 * (r % 32), 32 * (r % 32), r / 32, scr, lane); }
    else if (set == 1) for (int it = gw; it < I2 + I3; it += NGW) { int r = it;
        if (r < I2) { tr_item(INP(I_WINO), 2 * D, D, (bf16*)(ws + WS_WINO), 32 * (r % 64), 32 * (r % 64), r / 64, scr, lane, INP(I_LFG), INP(I_LFB), PG, PB, VEC_INO); continue; } r -= I2;
        tr_item(INP(I_WOUTO), D, D, (bf16*)(ws + WS_WOUTO), 32 * (r % 32), 32 * (r % 32), r / 32, scr, lane); }
    else for (int it = gw; it < I5 + I7; it += NGW) { int r = it;
        if (r < I5) { const int sc = 32 * (r % 176); const int dr = sc < FF ? 256 * (sc / 128) + sc % 128 : 256 * ((sc - FF) / 128) + 128 + (sc - FF) % 128; tr_item(INP(I_WUP) + (size_t)D * FF2, FF2, D, (bf16*)(ws + WS_WUP1), sc, dr, r / 176, scr, lane, INP(I_LMG) + D, INP(I_LMB) + D, PG, PB, VEC_UP1); continue; } r -= I5;
        tr_item(INP(I_WDN) + (size_t)FF * D, D, FF, (bf16*)(ws + WS_WDN1), 32 * (r % 32), 32 * (r % 32), r / 32, scr, lane); }
}
__device__ __forceinline__ void p0_prologue(Frame& F) {
    const int gw = F.vcu * NWAVES + F.wave, NGW = F.G * NWAVES, lane = flane();
    unsigned char* ws = F.ws;
    for (int i = F.vcu * 512 + ftid(F); i < (int)(CTL_ZERO_BYTES / 4) - 8192; i += F.G * 512) F.ctl[8192 + i] = 0u;
    weights_set(F, 0, gw, NGW);
    if (F.G != 256) { weights_set(F, 1, gw, NGW); weights_set(F, 2, gw, NGW); }
    const float* bfp = INP(I_BF);
    __syncthreads();
    { LAS float* wl = (LAS float*)(F.lds + RING_OFF); const float* wf = INP(I_WINE) + 1536;
      for (int k = ftid(F); k < D; k += 512) { const f32x4 a = *(const GAS f32x4*)(wf + (size_t)k * ECOLS), c = *(const GAS f32x4*)(wf + (size_t)k * ECOLS + 4);
          wl[k] = a.x; wl[D + k] = a.y; wl[2 * D + k] = a.z; wl[3 * D + k] = a.w; wl[4 * D + k] = c.x; wl[5 * D + k] = c.y; wl[6 * D + k] = c.z; wl[7 * D + k] = c.w; } }
    __syncthreads();
    f32x4 wfr[8][4];
#pragma unroll
    for (int hh = 0; hh < 8; ++hh)
#pragma unroll
        for (int j = 0; j < 4; ++j) wfr[hh][j] = *(const LAS f32x4*)((LAS float*)(F.lds + RING_OFF) + hh * D + 4 * lane + 256 * j);
    f32x4 vn[4];
    if (gw < M) { const GAS f32x4* xr = (const GAS f32x4*)(gw < MP ? INP(I_XP) + (size_t)gw * D : INP(I_XS) + (size_t)(gw - MP) * D) + lane;
#pragma unroll
        for (int j = 0; j < 4; ++j) vn[j] = xr[64 * j]; }
    for (int m = gw; m < M; m += NGW) {
        f32x4 v[4];
#pragma unroll
        for (int j = 0; j < 4; ++j) v[j] = vn[j];
        if (m + NGW < M) { const int mn = m + NGW; const GAS f32x4* xr = (const GAS f32x4*)(mn < MP ? INP(I_XP) + (size_t)mn * D : INP(I_XS) + (size_t)(mn - MP) * D) + lane;
#pragma unroll
            for (int j = 0; j < 4; ++j) vn[j] = xr[64 * j]; }
        GAS unsigned long long* o8 = (GAS unsigned long long*)((bf16*)(ws + WS_XA) + (size_t)m * D) + lane;
#pragma unroll
        for (int j = 0; j < 4; ++j) o8[64 * j] = (unsigned long long)pk2(v[j].x, v[j].y) | ((unsigned long long)pk2(v[j].z, v[j].w) << 32);
        float fh[8];
#pragma unroll
        for (int hh = 0; hh < 8; ++hh) { f32x4 t = v[0] * wfr[hh][0]; t += v[1] * wfr[hh][1]; t += v[2] * wfr[hh][2]; t += v[3] * wfr[hh][3]; fh[hh] = (t.x + t.y) + (t.z + t.w); }
        float f0 = fh[0], f1 = fh[1], f2 = fh[2], f3 = fh[3], f4 = fh[4], f5 = fh[5], f6 = fh[6], f7 = fh[7];
        f0 = wave_sum(f0); f1 = wave_sum(f1); f2 = wave_sum(f2); f3 = wave_sum(f3); f4 = wave_sum(f4); f5 = wave_sum(f5); f6 = wave_sum(f6); f7 = wave_sum(f7);
        if (lane < 8) { float fv = f0; fv = lane == 1 ? f1 : fv; fv = lane == 2 ? f2 : fv; fv = lane == 3 ? f3 : fv; fv = lane == 4 ? f4 : fv; fv = lane == 5 ? f5 : fv; fv = lane == 6 ? f6 : fv; fv = lane == 7 ? f7 : fv;
            const float lf = log_sigmoid_f(fv + bfp[lane]);
            if (m < MP) F.out[O_LFP + (size_t)m * NH + lane] = lf; else F.out[O_LFS + (size_t)(m - MP) * NH + lane] = lf; }
    }
    { bf16* WAT = (bf16*)(ws + WS_WAT); bf16* WXT = (bf16*)(ws + WS_WXT);
      for (int e = F.vcu * 512 + ftid(F); e < 8 * 64 * 64; e += F.G * 512) { const int nn = e >> 12, dd = (e >> 6) & 63, c = e & 63; WAT[e] = (bf16)f2bf(INP(I_RWA)[nn * 4096 + c * 64 + dd]); WXT[e] = (bf16)f2bf(INP(I_RWX)[nn * 4096 + c * 64 + dd]); } }
}

__device__ __forceinline__ void p2_scans(Frame& F, int gw, int NGW) {
    const int lane = flane();
    float* KBP = (float*)(F.ws + WS_KBP); float* KBS = (float*)(F.ws + WS_KBS);
    for (int it = gw; it < 32 + 256; it += NGW) {
        if (it < 32) { const int b = it >> 3, h = it & 7; const float* lf = F.out + O_LFP + (size_t)b * TP * NH + h;
            double s = 0.0;
#pragma unroll 16
            for (int i = 0; i < 64; ++i) s += (double)lf[(size_t)(64 * lane + i) * NH];
            double inc = s;
#pragma unroll
            for (int o = 1; o < 64; o <<= 1) { const double t = __shfl_up(inc, o); if (lane >= o) inc += t; }
            double run = inc - s;
#pragma unroll 16
            for (int i = 0; i < 64; ++i) { run += (double)lf[(size_t)(64 * lane + i) * NH]; KBP[(size_t)it * TP + 64 * lane + i] = (float)(-run * 1.4426950408889634); }
        } else { const int sid = it - 32, b = sid >> 3, h = sid & 7;
            { double inc = (double)F.out[O_LFS + (size_t)(b * TS + lane) * NH + h];
#pragma unroll
              for (int o = 1; o < 64; o <<= 1) { const double t = __shfl_up(inc, o); if (lane >= o) inc += t; }
              KBS[(size_t)sid * 2112 + PAST + lane] = (float)(-inc * 1.4426950408889634); }
            const float* lc = INP(I_CLF) + (size_t)b * PAST * NH + h;
            double s = 0.0;
#pragma unroll 16
            for (int i = 0; i < 32; ++i) s += (double)lc[(size_t)(32 * lane + i) * NH];
            double inc = s;
#pragma unroll
            for (int o = 1; o < 64; o <<= 1) { const double t = __shfl_down(inc, o); if (lane + o < 64) inc += t; }
            double run = inc - s;
            for (int i = 31; i >= 0; --i) { const int sx = 32 * lane + i; KBS[(size_t)sid * 2112 + sx] = (float)(run * 1.4426950408889634); run += (double)lc[(size_t)sx * NH]; }
        }
    }
}

__device__ __forceinline__ void p2_vecs(Frame& F, int v_lo, int v_hi, int gt0, int NTH) {
    const float* PG = (const float*)(F.ws + WS_PGB); const float* PB = PG + 16 * NVEC; float* GV = (float*)(F.ws + WS_GBV); float* BV = GV + NVEC;
    for (int i = v_lo + gt0; i < v_hi; i += NTH) { float g = 0.f, b = 0.f;
#pragma unroll
        for (int kb = 0; kb < 16; ++kb) { g += PG[(size_t)kb * NVEC + i]; b += PB[(size_t)kb * NVEC + i]; }
        GV[i] = g; BV[i] = b; }
}
constexpr int CW_NRM = 16384, NRM_QP = 0, NRM_KP = 512;
constexpr float PRUNE_T = 40.f;
__device__ __forceinline__ void p2_norms(Frame& F) {
    const bf16* Q = (const bf16*)(F.ws + WS_Q); const bf16* K = (const bf16*)(F.ws + WS_K); unsigned* NRM = (unsigned*)(F.ctl + CW_NRM);
    const int lane = flane(), hh = lane >> 3, part = lane & 7;
    for (int w = F.vcu * NWAVES + F.wave; w < MP / 8; w += F.G * NWAVES) { const int row0 = w * 8; float qm = 0.f, km = 0.f;
#pragma unroll 4
        for (int r = 0; r < 8; ++r) { float qv[8], kv[8]; unpack8(*(const GAS v4u*)(Q + (size_t)(row0 + r) * AW + hh * 64 + part * 8), qv); unpack8(*(const GAS v4u*)(K + (size_t)(row0 + r) * AW + hh * 64 + part * 8), kv);
            float q2 = 0.f, k2 = 0.f;
#pragma unroll
            for (int i = 0; i < 8; ++i) { q2 += qv[i] * qv[i]; k2 += kv[i] * kv[i]; }
            q2 += __shfl_xor(q2, 1); q2 += __shfl_xor(q2, 2); q2 += __shfl_xor(q2, 4); k2 += __shfl_xor(k2, 1); k2 += __shfl_xor(k2, 2); k2 += __shfl_xor(k2, 4);
            qm = fmaxf(qm, q2); km = fmaxf(km, k2); }
        if (part == 0) { const int b = row0 >> 12, qb = (row0 & (TP - 1)) >> 8; const float qn = sqrtf(qm) * 1.0001f, kn = sqrtf(km) * 1.0001f;
            atomicMax(NRM + NRM_QP + (b * 8 + hh) * 16 + qb, __float_as_uint(qn)); atomicMax(NRM + NRM_KP + b * 8 + hh, __float_as_uint(kn)); } }
}

constexpr int RG_PITCH = 72, RG_WAVE_LDS = 64 * RG_PITCH * 2;
__device__ __forceinline__ void rg_wave_item(Frame& F, int it, int pass, int ntq = -1) {
    LAS bf16* xt = (LAS bf16*)(F.lds + RING_OFF + F.wave * RG_WAVE_LDS);
    int b, n, chunk, row0; bool samp;
    if (it < 2048) { chunk = it & 63; n = (it >> 6) & 7; b = it >> 9; row0 = b * TP + chunk * 64; samp = false; }
    else { const int s = it - 2048; n = s & 7; b = s >> 3; chunk = 0; row0 = MP + b * TS; samp = true; }
    const int lane = flane(), fr = lane & 15, fq = lane >> 4;
    const bf16* XB = (const bf16*)(F.ws + WS_XB); const bf16* GB = (const bf16*)(F.ws + WS_GB); bf16* MIX = (bf16*)(F.ws + WS_MIX);
    float* CA = (float*)(F.ws + WS_CARRY); float* CH = CA + 2304 * 64;
    const bf16* WAT = (const bf16*)(F.ws + WS_WAT) + (size_t)n * 4096; const bf16* WXT = (const bf16*)(F.ws + WS_WXT) + (size_t)n * 4096;
    bf16x8 brA[4][2], biA[4][2]; float barA[4], bixA[4], lamA[4];
#pragma unroll
    for (int nt = 0; nt < 4; ++nt) { const int d = 16 * nt + fr;
#pragma unroll
        for (int ks = 0; ks < 2; ++ks) { brA[nt][ks] = *(const GAS bf16x8*)(WAT + d * 64 + 32 * ks + 8 * fq); biA[nt][ks] = *(const GAS bf16x8*)(WXT + d * 64 + 32 * ks + 8 * fq); }
        barA[nt] = INP(I_RBA)[n * 64 + d]; bixA[nt] = INP(I_RBX)[n * 64 + d]; lamA[nt] = INP(I_RLAM)[n * 64 + d]; }
    float hin[4];
    if (pass == 2) {
#pragma unroll
        for (int nt = 0; nt < 4; ++nt) { if (ntq >= 0 && nt != ntq) { hin[nt] = 0.f; continue; } const int d = 16 * nt + fr; float h = samp ? INP(I_SRH)[(size_t)b * BW + n * 64 + d] : 0.f;
            if (chunk > 0) { const int S4 = (chunk + 3) >> 2, c_lo = fq * S4, c_hi = min(c_lo + S4, chunk); float Aq = 1.f, Hq = 0.f;
#pragma unroll 4
                for (int cc = c_lo; cc < c_hi; ++cc) { const size_t pit = (size_t)(it - chunk + cc) * 64 + d; const float ca = CA[pit], chv = CH[pit]; Hq = ca * Hq + chv; Aq *= ca; }
#pragma unroll
                for (int g = 0; g < 4; ++g) { const float ag = __shfl(Aq, fr + 16 * g), hg = __shfl(Hq, fr + 16 * g); h = ag * h + hg; } }
            hin[nt] = h; } }
    { const int cq = lane & 7, tg = lane >> 3, ch0 = n * 64 + cq * 8;
      float w0[8], w1[8], w2[8], w3[8], cb[8];
#pragma unroll
      for (int q = 0; q < 2; ++q) { const f32x4 a = *(const GAS f32x4*)(INP(I_RCW) + ch0 + 4 * q), b1 = *(const GAS f32x4*)(INP(I_RCW) + BW + ch0 + 4 * q), c1 = *(const GAS f32x4*)(INP(I_RCW) + 2 * BW + ch0 + 4 * q),
            d1 = *(const GAS f32x4*)(INP(I_RCW) + 3 * BW + ch0 + 4 * q), e1 = *(const GAS f32x4*)(INP(I_RCB) + ch0 + 4 * q);
#pragma unroll
          for (int i = 0; i < 4; ++i) { w0[4 * q + i] = a[i]; w1[4 * q + i] = b1[i]; w2[4 * q + i] = c1[i]; w3[4 * q + i] = d1[i]; cb[4 * q + i] = e1[i]; } }
      float x0[8], x1[8], x2[8];
      const int tfirst = 8 * tg;
#pragma unroll
      for (int j = 0; j < 3; ++j) { const int t = tfirst - 3 + j; float v[8];
          if (chunk == 0 && t < 0) {
              if (samp) { const float* sp = INP(I_SRC) + ((size_t)b * 3 + (t + 3)) * BW + ch0;
#pragma unroll
                  for (int i = 0; i < 8; ++i) v[i] = sp[i]; }
              else {
#pragma unroll
                  for (int i = 0; i < 8; ++i) v[i] = 0.f; } }
          else unpack8(*(const GAS v4u*)(XB + (size_t)(row0 + t) * BW + ch0), v);
#pragma unroll
          for (int i = 0; i < 8; ++i) { if (j == 0) x0[i] = v[i]; else if (j == 1) x1[i] = v[i]; else x2[i] = v[i]; } }
#pragma unroll
      for (int j = 0; j < 8; ++j) { const int t = tfirst + j; float x3[8], y[8]; unpack8(*(const GAS v4u*)(XB + (size_t)(row0 + t) * BW + ch0), x3);
#pragma unroll
          for (int i = 0; i < 8; ++i) { y[i] = cb[i] + w0[i] * x0[i] + w1[i] * x1[i] + w2[i] * x2[i] + w3[i] * x3[i]; x0[i] = x1[i]; x1[i] = x2[i]; x2[i] = x3[i]; }
          *(LAS v4u*)(xt + t * RG_PITCH + cq * 8) = pack8(y); } }
    bf16x8 af[4][2];
#pragma unroll
    for (int m = 0; m < 4; ++m)
#pragma unroll
        for (int ks = 0; ks < 2; ++ks) af[m][ks] = *(const LAS bf16x8*)(xt + ((fr >> 2) * 16 + 4 * m + (fr & 3)) * RG_PITCH + 32 * ks + 8 * fq);
#pragma unroll
    for (int nt = 0; nt < 4; ++nt) { if (ntq >= 0 && nt != ntq) continue; const int d = 16 * nt + fr, ch = n * 64 + d;
        const bf16x8 (&br)[2] = brA[nt]; const bf16x8 (&bi)[2] = biA[nt];
        const float bar = barA[nt], bix = bixA[nt]; const float sp8 = 8.f * LOG2E * log1pf(expf(-lamA[nt]));
        float a[16], u[16];
#pragma unroll
        for (int m = 0; m < 4; ++m) { f32x4 ar = {0.f, 0.f, 0.f, 0.f}, ai = {0.f, 0.f, 0.f, 0.f};
#pragma unroll
            for (int ks = 0; ks < 2; ++ks) { ar = __builtin_amdgcn_mfma_f32_16x16x32_bf16(af[m][ks], br[ks], ar, 0, 0, 0); ai = __builtin_amdgcn_mfma_f32_16x16x32_bf16(af[m][ks], bi[ks], ai, 0, 0, 0); }
#pragma unroll
            for (int r = 0; r < 4; ++r) { const int t = fq * 16 + 4 * m + r;
                const float gr = __builtin_amdgcn_rcpf(1.f + __builtin_amdgcn_exp2f(-LOG2E * (ar[r] + bar))), gi = __builtin_amdgcn_rcpf(1.f + __builtin_amdgcn_exp2f(-LOG2E * (ai[r] + bix)));
                const float av = __builtin_amdgcn_exp2f(-sp8 * gr); const float xcv = bf2f(xt[t * RG_PITCH + d]);
                a[4 * m + r] = av; u[4 * m + r] = __builtin_amdgcn_sqrtf(fmaxf(1.f - av * av, 0.f)) * gi * xcv; } }
        float A = 1.f, Hh = 0.f;
#pragma unroll
        for (int k = 0; k < 16; ++k) { Hh = a[k] * Hh + u[k]; A *= a[k]; }
        float Ag[4], Hg[4];
#pragma unroll
        for (int g = 0; g < 4; ++g) { Ag[g] = __shfl(A, fr + 16 * g); Hg[g] = __shfl(Hh, fr + 16 * g); }
        if (pass == 1) { float At = 1.f, Ht = 0.f;
#pragma unroll
            for (int g = 0; g < 4; ++g) { Ht = Ag[g] * Ht + Hg[g]; At *= Ag[g]; }
            if (fq == 0) { CA[(size_t)it * 64 + d] = At; CH[(size_t)it * 64 + d] = Ht; } }
        else { float h = hin[nt];
#pragma unroll
            for (int g = 0; g < 3; ++g) if (g < fq) h = Ag[g] * h + Hg[g];
#pragma unroll
            for (int k = 0; k < 16; ++k) { h = a[k] * h + u[k]; xt[(fq * 16 + k) * RG_PITCH + d] = (bf16)f2bf(h); }
            if (fq == 3 && (samp || chunk == 63)) F.out[(samp ? O_RHS : O_RHP) + (size_t)b * BW + ch] = h; }
    }
    if (pass == 2) { const int cq = lane & 7, tg = lane >> 3;
        if (ntq < 0 || (cq >> 1) == ntq) { v4u gw8[8];
#pragma unroll
            for (int j = 0; j < 8; ++j) gw8[j] = *(const GAS v4u*)(GB + (size_t)(row0 + 8 * tg + j) * BW + n * 64 + cq * 8);
#pragma unroll
            for (int j = 0; j < 8; ++j) { const int t = 8 * tg + j; float hv[8], gv[8]; unpack8(*(const LAS v4u*)(xt + t * RG_PITCH + cq * 8), hv); unpack8(gw8[j], gv);
#pragma unroll
                for (int i = 0; i < 8; ++i) hv[i] *= gv[i];
                *(GAS v4u*)(MIX + (size_t)(row0 + t) * D + AW + n * 64 + cq * 8) = pack8(hv); } } }
}

namespace att {
typedef short bf16x8 __attribute__((ext_vector_type(8)));
typedef short s16x4 __attribute__((ext_vector_type(4)));
typedef float f32x16 __attribute__((ext_vector_type(16)));
typedef unsigned u32x4 __attribute__((ext_vector_type(4)));
typedef float f32x2_t __attribute__((ext_vector_type(2))); typedef __bf16 bf16x2_t __attribute__((ext_vector_type(2)));
__device__ __forceinline__ int crow(int r, int hi) { return (r & 3) + 8 * (r >> 2) + 4 * hi; }
__device__ __forceinline__ unsigned cvtpk_s(float lo, float hi) { f32x2_t v = {lo, hi}; bf16x2_t b = __builtin_convertvector(v, bf16x2_t); return __builtin_bit_cast(unsigned, b); }
__device__ __forceinline__ s16x4 vtr(const LAS char* p) { return __builtin_bit_cast(s16x4, __builtin_amdgcn_ds_read_tr16_b64_v4i16((LAS s16x4*)p)); }
__device__ __forceinline__ void qkt(f32x16& p0, f32x16& p1, const LAS char* Kslot, const bf16x8 (&qr)[4], int r32, int hi) {
    const LAS char* kb = Kslot + hi * 1024 + r32 * 16;
    f32x16 z0 = {}, z1 = {};
#pragma unroll
    for (int d0 = 0; d0 < 4; ++d0) { const bf16x8 b0 = *(const LAS bf16x8*)(kb + d0 * 2048); const bf16x8 b1 = *(const LAS bf16x8*)(kb + d0 * 2048 + 512);
        z0 = __builtin_amdgcn_mfma_f32_32x32x16_bf16(b0, qr[d0], z0, 0, 0, 0); z1 = __builtin_amdgcn_mfma_f32_32x32x16_bf16(b1, qr[d0], z1, 0, 0, 0); }
    p0 = z0; p1 = z1;
}
__device__ __forceinline__ void pv(f32x16 (&o)[2], const LAS char* vp, bf16x8 pa0, bf16x8 pa1, bf16x8 pa2, bf16x8 pa3) {
#pragma unroll
    for (int d0 = 0; d0 < 2; ++d0) { bf16x8 vf[4];
#pragma unroll
        for (int ks = 0; ks < 4; ++ks) { const s16x4 lo = vtr(vp + d0 * 4096 + ks * 1024), hi = vtr(vp + d0 * 4096 + ks * 1024 + 512); vf[ks] = (bf16x8){lo[0], lo[1], lo[2], lo[3], hi[0], hi[1], hi[2], hi[3]}; }
        o[d0] = __builtin_amdgcn_mfma_f32_32x32x16_bf16(pa0, vf[0], o[d0], 0, 0, 0); o[d0] = __builtin_amdgcn_mfma_f32_32x32x16_bf16(pa1, vf[1], o[d0], 0, 0, 0);
        o[d0] = __builtin_amdgcn_mfma_f32_32x32x16_bf16(pa2, vf[2], o[d0], 0, 0, 0); o[d0] = __builtin_amdgcn_mfma_f32_32x32x16_bf16(pa3, vf[3], o[d0], 0, 0, 0); }
}
__device__ __forceinline__ void load_kb(f32x4 (&kb)[8], const float* kbt0, int hi) {
#pragma unroll
    for (int g = 0; g < 4; ++g) { kb[g] = *(const GAS f32x4*)(kbt0 + 4 * hi + 8 * g); kb[4 + g] = *(const GAS f32x4*)(kbt0 + 4 * hi + 32 + 8 * g); }
}
__device__ __forceinline__ void tile_step(float& m_run, float& l_run, f32x16 (&o)[2], const LAS char* Kslot, const LAS char* vp, const bf16x8 (&qr)[4], const f32x4 (&kb)[8], int kpos0, int qpos, bool need_mask, LAS float* wsf, int r32, int hi) {
    f32x16 p0, p1; qkt(p0, p1, Kslot, qr, r32, hi);
#pragma unroll
    for (int g = 0; g < 4; ++g) { const f32x4 b0 = kb[g], b1 = kb[4 + g];
#pragma unroll
        for (int e = 0; e < 4; ++e) { p0[4 * g + e] += b0[e]; p1[4 * g + e] += b1[e]; } }
    if (need_mask) {
#pragma unroll
        for (int r = 0; r < 16; ++r) { const int kv = kpos0 + crow(r, hi); if (kv > qpos) p0[r] = -INFINITY; if (kv + 32 > qpos) p1[r] = -INFINITY; } }
    float rm = fmaxf(p0[0], p1[0]);
#pragma unroll
    for (int r = 1; r < 16; ++r) rm = fmaxf(rm, fmaxf(p0[r], p1[r]));
    rm = fmaxf(rm, __shfl_xor(rm, 32));
    const float mn = fmaxf(m_run, rm); const float f = __builtin_amdgcn_exp2f(m_run - mn); m_run = mn;
    float rs = 0.f;
#pragma unroll
    for (int r = 0; r < 16; ++r) { p0[r] = __builtin_amdgcn_exp2f(p0[r] - mn); p1[r] = __builtin_amdgcn_exp2f(p1[r] - mn); rs += p0[r] + p1[r]; }
    l_run = l_run * f + rs;
    if (hi == 0) wsf[r32] = f;
#pragma unroll
    for (int r = 0; r < 16; ++r) { const float fr_ = wsf[crow(r, hi)]; o[0][r] *= fr_; o[1][r] *= fr_; }
    u32x4 pw0, pw1, pw2, pw3;
    pw0 = (u32x4){cvtpk_s(p0[0], p0[1]), cvtpk_s(p0[2], p0[3]), cvtpk_s(p0[4], p0[5]), cvtpk_s(p0[6], p0[7])}; pw1 = (u32x4){cvtpk_s(p0[8], p0[9]), cvtpk_s(p0[10], p0[11]), cvtpk_s(p0[12], p0[13]), cvtpk_s(p0[14], p0[15])};
    pw2 = (u32x4){cvtpk_s(p1[0], p1[1]), cvtpk_s(p1[2], p1[3]), cvtpk_s(p1[4], p1[5]), cvtpk_s(p1[6], p1[7])}; pw3 = (u32x4){cvtpk_s(p1[8], p1[9]), cvtpk_s(p1[10], p1[11]), cvtpk_s(p1[12], p1[13]), cvtpk_s(p1[14], p1[15])};
    pv(o, vp, __builtin_bit_cast(bf16x8, pw0), __builtin_bit_cast(bf16x8, pw1), __builtin_bit_cast(bf16x8, pw2), __builtin_bit_cast(bf16x8, pw3));
}
struct KV { const bf16* k0; const bf16* v0; const bf16* k1; const bf16* v1; int nt0; };
__device__ __forceinline__ void unit(LAS unsigned char* lds, int tid, const bf16* Qrows, int nqw, const KV S, int t_begin, int NT, const float* kbias, int qpos0, bf16* Odst) {
    const int lane = tid & 63, wid = __builtin_amdgcn_readfirstlane(tid >> 6), r32 = lane & 31, hi = lane >> 5;
    const bool active = wid < nqw;
    LAS char* Kb = (LAS char*)lds; LAS char* Vb = Kb + 16384; LAS float* wsf = (LAS float*)(Kb + 32768) + wid * 64; LAS bf16* stg = (LAS bf16*)(Kb + 32768 + 2048) + wid * 2048;
    bf16x8 qr[4];
#pragma unroll
    for (int d0 = 0; d0 < 4; ++d0) qr[d0] = active ? *(const GAS bf16x8*)(Qrows + (size_t)(wid * 32 + r32) * 512 + d0 * 16 + hi * 8) : (bf16x8){0, 0, 0, 0, 0, 0, 0, 0};
    float m_run = -INFINITY, l_run = 0.f; f32x16 o[2]; o[0] = f32x16{}; o[1] = f32x16{};
    const int qlo = qpos0 + wid * 32, qhi = qlo + 31, qpos = qlo + r32;
    const size_t koff = (size_t)lane * 512 + wid * 8, voff = (size_t)(16 * (wid & 3) + (lane >> 2)) * 512 + (wid >> 2) * 32 + (lane & 3) * 8;
    const int ldst = wid * 1024 + lane * 16;
    const LAS char* vp0 = Vb + ((lane >> 4) & 1) * 32 + (lane & 3) * 8 + (4 * hi + ((lane & 15) >> 2)) * 64;
    u32x4 kreg, vreg;
    { const int tn = t_begin; const bf16* kt = tn < S.nt0 ? S.k0 + (size_t)tn * 64 * 512 : S.k1 + (size_t)(tn - S.nt0) * 64 * 512; const bf16* vt = tn < S.nt0 ? S.v0 + (size_t)tn * 64 * 512 : S.v1 + (size_t)(tn - S.nt0) * 64 * 512;
      kreg = *(const GAS u32x4*)(kt + koff); vreg = *(const GAS u32x4*)(vt + voff); }
    { const int s0 = (t_begin & 1) * 8192; *(LAS u32x4*)(Kb + s0 + ldst) = kreg; *(LAS u32x4*)(Vb + s0 + ldst) = vreg; }
    f32x4 kbc[8], kbn[8]; load_kb(kbc, kbias + 64 * t_begin, hi);
    __syncthreads();
    for (int t = t_begin; t < NT; ++t) {
        const int slot = (t & 1) * 8192;
        if (t + 1 < NT) load_kb(kbn, kbias + 64 * (t + 1), hi);
        if (t + 1 < NT) { const int tn = t + 1; const bf16* kt = tn < S.nt0 ? S.k0 + (size_t)tn * 64 * 512 : S.k1 + (size_t)(tn - S.nt0) * 64 * 512; const bf16* vt = tn < S.nt0 ? S.v0 + (size_t)tn * 64 * 512 : S.v1 + (size_t)(tn - S.nt0) * 64 * 512;
            kreg = *(const GAS u32x4*)(kt + koff); vreg = *(const GAS u32x4*)(vt + voff); }
        if (active && 64 * t <= qhi) tile_step(m_run, l_run, o, Kb + slot, vp0 + slot, qr, kbc, 64 * t, qpos, 64 * t + 63 > qlo, wsf, r32, hi);
#pragma unroll
        for (int g = 0; g < 8; ++g) kbc[g] = kbn[g];
        if (t + 1 < NT) { const int ns = ((t + 1) & 1) * 8192; *(LAS u32x4*)(Kb + ns + ldst) = kreg; *(LAS u32x4*)(Vb + ns + ldst) = vreg; }
        __syncthreads();
    }
    if (active) {
        const float lt = l_run + __shfl_xor(l_run, 32);
        if (hi == 0) wsf[32 + r32] = lt;
#pragma unroll
        for (int r = 0; r < 16; ++r) { const int orow = crow(r, hi); const float rl = 1.0f / wsf[32 + orow];
            stg[orow * 64 + r32] = (bf16)f2bf(o[0][r] * rl); stg[orow * 64 + 32 + r32] = (bf16)f2bf(o[1][r] * rl); }
#pragma unroll
        for (int i = 0; i < 4; ++i) { const int row = i * 8 + (lane >> 3), ch = lane & 7; const u32x4 v = *(const LAS u32x4*)(stg + row * 64 + ch * 8); *(GAS u32x4*)(Odst + (size_t)(wid * 32 + row) * D + ch * 8) = v; }
    }
    __syncthreads();
}
__device__ __forceinline__ void unit_sample(LAS unsigned char* lds, int tid, int b, int h, const bf16* Q, const bf16* Kn, const bf16* Vn, const float* Kc, const float* Vc, const float* kbias, bf16* MIXp) {
    const int lane = tid & 63, wid = __builtin_amdgcn_readfirstlane(tid >> 6), r32 = lane & 31, hi = lane >> 5, qh = wid & 1, sp = wid >> 1;
    LAS char* Kb = (LAS char*)lds + sp * 16384; LAS char* Vb = Kb + 8192; LAS float* wsf = (LAS float*)((LAS char*)lds + 131584) + wid * 64;
    const size_t qrow0 = (size_t)MP + (size_t)b * TS;
    bf16x8 qr[4];
#pragma unroll
    for (int d0 = 0; d0 < 4; ++d0) qr[d0] = *(const GAS bf16x8*)(Q + (qrow0 + qh * 32 + r32) * AW + h * 64 + d0 * 16 + hi * 8);
    float m_run = -INFINITY, l_run = 0.f; f32x16 o[2]; o[0] = f32x16{}; o[1] = f32x16{};
    const int qpos = PAST + qh * 32 + r32, qlo = PAST + qh * 32;
    const LAS char* vp0 = Vb + ((lane >> 4) & 1) * 32 + (lane & 3) * 8 + (4 * hi + ((lane & 15) >> 2)) * 64;
    const int ls = qh * 64 + lane;
    f32x4 kf[4][2], vf[4][2];
#define SLOAD(t) do { const size_t rb_ = ((size_t)b * PAST + 64 * (size_t)(t)) * AW + h * 64; _Pragma("unroll") for (int i_ = 0; i_ < 4; ++i_) { const int e_ = ls + 128 * i_; \
        const GAS f32x4* kp_ = (const GAS f32x4*)(Kc + rb_ + (size_t)(e_ >> 3) * AW + (e_ & 7) * 8); kf[i_][0] = kp_[0]; kf[i_][1] = kp_[1]; \
        const GAS f32x4* vq_ = (const GAS f32x4*)(Vc + rb_ + (size_t)(e_ >> 3) * AW + (e_ & 7) * 8); vf[i_][0] = vq_[0]; vf[i_][1] = vq_[1]; } } while (0)
#define VIDX(e_) (((((e_) & 7) >> 2) * 4 + ((e_) >> 7)) * 64 + (((e_) >> 3) & 15) * 4 + ((e_) & 3))
#define SSTORE(bo_) do { _Pragma("unroll") for (int i_ = 0; i_ < 4; ++i_) { const int e_ = ls + 128 * i_; u32x4 w_; \
        w_.x = cvtpk_s(kf[i_][0][0], kf[i_][0][1]); w_.y = cvtpk_s(kf[i_][0][2], kf[i_][0][3]); w_.z = cvtpk_s(kf[i_][1][0], kf[i_][1][1]); w_.w = cvtpk_s(kf[i_][1][2], kf[i_][1][3]); *(LAS u32x4*)(Kb + (bo_) + (e_ & 7) * 1024 + (e_ >> 3) * 16) = w_; \
        w_.x = cvtpk_s(vf[i_][0][0], vf[i_][0][1]); w_.y = cvtpk_s(vf[i_][0][2], vf[i_][0][3]); w_.z = cvtpk_s(vf[i_][1][0], vf[i_][1][1]); w_.w = cvtpk_s(vf[i_][1][2], vf[i_][1][3]); *(LAS u32x4*)(Vb + (bo_) + VIDX(e_) * 16) = w_; } } while (0)
    SLOAD(sp);
    SSTORE(0);
    f32x4 kbc[8];
    __syncthreads();
    for (int s = 0; s < 8; ++s) {
        const int t = 4 * s + sp; const int cur = (s & 1) * 65536, nxt = 65536 - cur;
        load_kb(kbc, kbias + 64 * t, hi);
        if (s < 7) SLOAD(t + 4);
        tile_step(m_run, l_run, o, Kb + cur, vp0 + cur, qr, kbc, 64 * t, qpos, false, wsf, r32, hi);
        if (s < 7) SSTORE(nxt);
        else if (sp == 0) {
#pragma unroll
            for (int i_ = 0; i_ < 4; ++i_) { const int e_ = ls + 128 * i_;
                *(LAS u32x4*)(Kb + nxt + (e_ & 7) * 1024 + (e_ >> 3) * 16) = *(const GAS u32x4*)(Kn + (qrow0 + (e_ >> 3)) * AW + h * 64 + (e_ & 7) * 8);
                *(LAS u32x4*)(Vb + nxt + VIDX(e_) * 16) = *(const GAS u32x4*)(Vn + (qrow0 + (e_ >> 3)) * AW + h * 64 + (e_ & 7) * 8); } }
        __syncthreads();
    }
    if (sp == 0) { load_kb(kbc, kbias + 64 * 32, hi); tile_step(m_run, l_run, o, Kb, vp0, qr, kbc, 64 * 32, qpos, true, wsf, r32, hi); }
#undef SLOAD
#undef SSTORE
#undef VIDX
    __syncthreads();
    LAS float* cb = (LAS float*)lds + wid * (32 * 65); LAS float* ml = (LAS float*)((LAS char*)lds + 8 * 32 * 65 * 4) + wid * 64;
    { const float lt = l_run + __shfl_xor(l_run, 32); if (hi == 0) { ml[r32] = m_run; ml[32 + r32] = lt; }
#pragma unroll
      for (int r = 0; r < 16; ++r) { const int q = crow(r, hi); cb[q * 65 + r32] = o[0][r]; cb[q * 65 + 32 + r32] = o[1][r]; } }
    __syncthreads();
    if (sp == 0) { const int q = lane & 31, dh = lane >> 5;
        float mt = -INFINITY, w[4], lt = 0.f;
#pragma unroll
        for (int s2 = 0; s2 < 4; ++s2) mt = fmaxf(mt, ((LAS float*)((LAS char*)lds + 8 * 32 * 65 * 4) + (2 * s2 + qh) * 64)[q]);
#pragma unroll
        for (int s2 = 0; s2 < 4; ++s2) { const LAS float* mls = (LAS float*)((LAS char*)lds + 8 * 32 * 65 * 4) + (2 * s2 + qh) * 64; w[s2] = __builtin_amdgcn_exp2f(mls[q] - mt); lt += w[s2] * mls[32 + q]; }
        const float rl = 1.0f / lt;
#pragma unroll
        for (int c8 = 0; c8 < 4; ++c8) { float ov[8];
#pragma unroll
            for (int i = 0; i < 8; ++i) { const int d = dh * 32 + c8 * 8 + i; float acc = 0.f;
#pragma unroll
                for (int s2 = 0; s2 < 4; ++s2) acc += w[s2] * ((LAS float*)lds + (2 * s2 + qh) * (32 * 65))[q * 65 + d];
                ov[i] = acc * rl; }
            *(GAS v4u*)(MIXp + (qrow0 + qh * 32 + q) * D + h * 64 + dh * 32 + c8 * 8) = pack8(ov); } }
    __syncthreads();
}
}

__device__ __forceinline__ void p3_mixer(Frame& F) {
    const bf16* Q = (const bf16*)(F.ws + WS_Q); const bf16* K = (const bf16*)(F.ws + WS_K); const bf16* V = (const bf16*)(F.ws + WS_V); bf16* MIX = (bf16*)(F.ws + WS_MIX);
    const float* KBP = (const float*)(F.ws + WS_KBP); const float* KBS = (const float*)(F.ws + WS_KBS); const unsigned* NRM = (const unsigned*)(F.ctl + CW_NRM);
    const bool sample_first = (blockIdx.x & 8) != 0;
    if (sample_first) for (int i = F.vcu; i < 256; i += F.G) att::unit_sample(F.lds + RING_OFF, ftid(F), i >> 3, i & 7, Q, K, V, INP(I_CK), INP(I_CV), KBS + (size_t)i * 2112, MIX);
    for (int i = F.vcu; i < 512; i += F.G) { const int j = i & 255, bh = j >> 3, s = j & 7, qb = i < 256 ? 15 - s : s, b = bh >> 3, h = bh & 7;
        const size_t r0 = (size_t)b * TP; att::KV S{K + r0 * AW + h * 64, V + r0 * AW + h * 64, K + r0 * AW + h * 64, V + r0 * AW + h * 64, 4 * qb + 4};
        const float qk2 = 2.f * __uint_as_float(__hip_atomic_load(NRM + NRM_QP + bh * 16 + qb, RLX_AGENT)) * __uint_as_float(__hip_atomic_load(NRM + NRM_KP + bh, RLX_AGENT)); const float* kbp = KBP + (size_t)bh * TP; const float thr = kbp[256 * qb] - PRUNE_T - qk2;
        int lo_; { const int ln = flane(); const float kv_ = ln < 4 * qb ? kbp[64 * ln + 63] : 3.0e38f; const unsigned long long keep = __ballot(kv_ >= thr); lo_ = keep ? (int)__builtin_ctzll(keep) : 4 * qb; lo_ = lo_ < 4 * qb ? lo_ : 4 * qb; }
        att::unit(F.lds + RING_OFF, ftid(F), Q + (r0 + 256 * qb) * AW + h * 64, 8, S, lo_, 4 * qb + 4, kbp, 256 * qb, MIX + (r0 + 256 * qb) * D + h * 64); }
    if (!sample_first) for (int i = F.vcu; i < 256; i += F.G) att::unit_sample(F.lds + RING_OFF, ftid(F), i >> 3, i & 7, Q, K, V, INP(I_CK), INP(I_CV), KBS + (size_t)i * 2112, MIX);
    { const int gw_ = F.vcu * NWAVES + F.wave, NGW_ = F.G * NWAVES;
      for (int it = gw_; it < 2048; it += NGW_) rg_wave_item(F, it, 2);
      if (NGW_ == 2048) { if (gw_ & 1) { const int q = gw_ >> 1; rg_wave_item(F, 2048 + (q >> 2), 2, q & 3); } }
      else for (int it = 2048 + gw_; it < 2304; it += NGW_) rg_wave_item(F, it, 2); }
    __syncthreads();
}

constexpr int LDSX_OFF = 131584;
static_assert(LDSX_OFF >= MISC_OFF + 128 && LDSX_OFF + 8192 <= LDS_BYTES, "LDS map: spare region");
__device__ __forceinline__ void stage_gb(Frame& F, const float* g, const float* b) {
    LAS float* d = (LAS float*)(F.lds + LDSX_OFF);
    for (int i = ftid(F); i < 1024; i += 512) { d[i] = g[i]; d[1024 + i] = b[i]; }
    __syncthreads();
}
typedef float mini_f32x16 __attribute__((ext_vector_type(16)));
__device__ __forceinline__ mini_f32x16 mini_acc(Frame& F, const bf16* A, const bf16* Bt, int K, int mb, int nb) {
    typedef float f32x16 __attribute__((ext_vector_type(16)));
    const int lane = flane(), wid = F.wave, tid = ftid(F), r32 = lane & 31, hi = lane >> 5, wm = wid & 1, wn = wid >> 1;
    LAS unsigned char* sb = F.lds + RING_OFF;
    const unsigned char* gsrc[6]; int ldst[6];
#pragma unroll
    for (int i = 0; i < 6; ++i) { const int item = tid + 512 * i; const int rr = item < 1024 ? (item >> 4) : ((item - 1024) >> 4), c = item & 15;
        gsrc[i] = item < 1024 ? (const unsigned char*)(A + (size_t)(MP + 64 * mb + rr) * K) + 16 * c : (const unsigned char*)(Bt + (size_t)(128 * nb + rr) * K) + 16 * c;
        ldst[i] = (item < 1024 ? 0 : 16384) + rr * 256 + ((c ^ (rr & 7)) << 4); }
    const int arow = 32 * wm + r32, brow = 32 * wn + r32;
    v4u stg[6];
#pragma unroll
    for (int i = 0; i < 6; ++i) stg[i] = *(const GAS v4u*)(gsrc[i]);
#pragma unroll
    for (int i = 0; i < 6; ++i) *(LAS v4u*)(sb + ldst[i]) = stg[i];
    __syncthreads();
    f32x16 acc = {};
    const int nq = K / 128;
    for (int q = 0; q < nq; ++q) { const int cur = (q & 1) * 49152;
        if (q + 1 < nq) {
#pragma unroll
            for (int i = 0; i < 6; ++i) stg[i] = *(const GAS v4u*)(gsrc[i] + 256 * (q + 1)); }
#pragma unroll
        for (int i = 0; i < 8; ++i) { const int c = 2 * i + hi;
            const bf16x8 xa = *(const LAS bf16x8*)(sb + cur + arow * 256 + ((c ^ (arow & 7)) << 4)), wb = *(const LAS bf16x8*)(sb + cur + 16384 + brow * 256 + ((c ^ (brow & 7)) << 4));
            acc = __builtin_amdgcn_mfma_f32_32x32x16_bf16(wb, xa, acc, 0, 0, 0); }
        if (q + 1 < nq) {
#pragma unroll
            for (int i = 0; i < 6; ++i) *(LAS v4u*)(sb + (49152 - cur) + ldst[i]) = stg[i]; }
        __syncthreads(); }
    return acc;
}
template <int MODE, bool OUT32>
__device__ __forceinline__ void mini_seam(Frame& F, const bf16* A, const bf16* Bt, int K, int unit, const float* xs, bf16* ZA, float* Z32, const float* st_in, const LAS float* gb_lds, float* st_out) {
    const int mb = unit >> 3, nb = unit & 7;
    const mini_f32x16 acc = mini_acc(F, A, Bt, K, mb, nb);
    const int lane = flane(), wid = F.wave, r32 = lane & 31, hi = lane >> 5, wm = wid & 1, wn = wid >> 1;
    const int row = MP + 64 * mb + 32 * wm + r32;
    const int c0 = 128 * nb + 32 * wn + 4 * hi; const float alpha = ALPHA;
    float mu = 0.f, rstd = 1.f;
    if (MODE == 1) { const float sm = st_in[2 * (size_t)row], sq2 = st_in[2 * (size_t)row + 1]; mu = sm * (1.0f / D); rstd = 1.0f / sqrtf(fmaxf(sq2 * (1.0f / D) - mu * mu, 0.f) + LN_EPS); }
    f32x4 res[4];
#pragma unroll
    for (int g = 0; g < 4; ++g) { const size_t o = (size_t)row * D + c0 + 8 * g;
        if (MODE == 0) res[g] = *(const GAS f32x4*)(xs + (o - (size_t)MP * D));
        else { const unsigned long long w = *(const GAS unsigned long long*)(ZA + o); const unsigned lo = (unsigned)w, hh = (unsigned)(w >> 32);
            const f32x4 zp = {__builtin_bit_cast(float, lo << 16), __builtin_bit_cast(float, lo & 0xffff0000u), __builtin_bit_cast(float, hh << 16), __builtin_bit_cast(float, hh & 0xffff0000u)};
            if (MODE == 2) res[g] = zp; else res[g] = (zp - mu) * rstd * *(const LAS f32x4*)(gb_lds + c0 + 8 * g) + *(const LAS f32x4*)(gb_lds + 1024 + c0 + 8 * g); } }
    asm volatile("" ::: "memory");
    float sacc = 0.f, qacc = 0.f;
#pragma unroll
    for (int g = 0; g < 4; ++g) { const size_t o = (size_t)row * D + c0 + 8 * g; const f32x4 z = res[g] * alpha + (f32x4){acc[4 * g], acc[4 * g + 1], acc[4 * g + 2], acc[4 * g + 3]};
        if (OUT32) *(GAS f32x4*)(Z32 + o) = z; else *(GAS unsigned long long*)(ZA + o) = (unsigned long long)pk2(z[0], z[1]) | ((unsigned long long)pk2(z[2], z[3]) << 32);
        sacc += (z[0] + z[1]) + (z[2] + z[3]); qacc += (z[0] * z[0] + z[1] * z[1]) + (z[2] * z[2] + z[3] * z[3]); }
    if (st_out) { sacc += __shfl_xor(sacc, 32); qacc += __shfl_xor(qacc, 32); if (hi == 0) { atomicAdd(st_out + 2 * (size_t)row, sacc); atomicAdd(st_out + 2 * (size_t)row + 1, qacc); } }
}

__device__ __forceinline__ void mini_ino(Frame& F, const bf16* A, const bf16* Bt, int unit, bf16* U, bf16* VB, const float* st, const float* G, const float* Bv, float* stv) {
    const int mb = unit >> 4, nb = unit & 15;
    const mini_f32x16 acc = mini_acc(F, A, Bt, D, mb, nb);
    const int lane = flane(), wid = F.wave, r32 = lane & 31, hi = lane >> 5, wm = wid & 1, wn = wid >> 1;
    const int row = MP + 64 * mb + 32 * wm + r32; const int c0 = 128 * nb + 32 * wn + 4 * hi; const bool isu = nb < 8;
    const pg8::f32x2 sq = *(const GAS pg8::f32x2*)(st + 2 * (size_t)row); const float mu = sq.x * (1.0f / D); const float rstd = 1.0f / sqrtf(fmaxf(sq.y * (1.0f / D) - mu * mu, 0.f) + LN_EPS);
    f32x4 gq[4], bq[4];
#pragma unroll
    for (int g = 0; g < 4; ++g) { gq[g] = *(const GAS f32x4*)(G + c0 + 8 * g); bq[g] = *(const GAS f32x4*)(Bv + c0 + 8 * g); }
    float sacc = 0.f, qacc = 0.f; bf16* dst = (isu ? U : VB) + (size_t)row * D + (c0 & 1023);
#pragma unroll
    for (int g = 0; g < 4; ++g) { const f32x4 a4 = {acc[4 * g], acc[4 * g + 1], acc[4 * g + 2], acc[4 * g + 3]}; const f32x4 v = pg8::gelu4((a4 - mu * gq[g]) * rstd + bq[g]);
        *(GAS unsigned long long*)(dst + 8 * g) = (unsigned long long)pk2(v[0], v[1]) | ((unsigned long long)pk2(v[2], v[3]) << 32);
        sacc += (v[0] + v[1]) + (v[2] + v[3]); qacc += (v[0] * v[0] + v[1] * v[1]) + (v[2] * v[2] + v[3] * v[3]); }
    if (!isu) { sacc += __shfl_xor(sacc, 32); qacc += __shfl_xor(qacc, 32); if (hi == 0) { atomicAdd(stv + 2 * (size_t)row, sacc); atomicAdd(stv + 2 * (size_t)row + 1, qacc); } }
}

__device__ __forceinline__ void final_ln_phase(Frame& F, const float* Z, const float* g, const float* bta) {
    const int gw = F.vcu * NWAVES + F.wave, NGW = F.G * NWAVES, lane = flane();
    f32x4 gv[4], bv[4];
#pragma unroll
    for (int j = 0; j < 4; ++j) { gv[j] = ((const GAS f32x4*)g)[lane + 64 * j]; bv[j] = ((const GAS f32x4*)bta)[lane + 64 * j]; }
    f32x4 vn[4];
    if (gw < M) { const GAS f32x4* zr = (const GAS f32x4*)(Z + (size_t)gw * D) + lane;
#pragma unroll
        for (int j = 0; j < 4; ++j) vn[j] = zr[64 * j]; }
    for (int m = gw; m < M; m += NGW) {
        float* orow = m < MP ? F.out + O_YP + (size_t)m * D : F.out + O_YS + (size_t)(m - MP) * D;
        f32x4 v[4]; float s = 0.f;
#pragma unroll
        for (int j = 0; j < 4; ++j) { v[j] = vn[j]; s += (v[j].x + v[j].y) + (v[j].z + v[j].w); }
        if (m + NGW < M) { const GAS f32x4* zr = (const GAS f32x4*)(Z + (size_t)(m + NGW) * D) + lane;
#pragma unroll
            for (int j = 0; j < 4; ++j) vn[j] = zr[64 * j]; }
        const float mean = wave_sum(s) * (1.f / D); float s2 = 0.f;
#pragma unroll
        for (int j = 0; j < 4; ++j) { v[j] = v[j] - mean; s2 += (v[j].x * v[j].x + v[j].y * v[j].y) + (v[j].z * v[j].z + v[j].w * v[j].w); }
        const float rstd = 1.f / sqrtf(wave_sum(s2) * (1.f / D) + LN_EPS);
        GAS f32x4* o4 = (GAS f32x4*)orow + lane;
#pragma unroll
        for (int j = 0; j < 4; ++j) __builtin_nontemporal_store(v[j] * rstd * gv[j] + bv[j], (f32x4*)(o4 + 64 * j));
    }
}
__device__ __forceinline__ void sgu_phase(Frame& F) {
    constexpr int PITCH = 136;
    LAS bf16* vT = (LAS bf16*)(F.lds + RING_OFF); LAS bf16* wT = vT + 128 * PITCH;
    const bf16* VN = (const bf16*)(F.ws + WS_VN); const bf16* U = (const bf16*)(F.ws + WS_U); bf16* G = (bf16*)(F.ws + WS_G); const float* STV = (const float*)(F.ctl + CW_STAT) + (size_t)3 * M * 2;
    const int tid = ftid(F), lane = flane(), wid = F.wave, fr = lane & 15, fq = lane >> 4;
    const int g = F.vcu & 7;
    for (int e = tid; e < 128 * 32; e += 512) { const int t = e >> 5, s4 = (e & 31) * 4; f32x4 w = *(const GAS f32x4*)(INP(I_SGW) + ((size_t)g * 128 + t) * 128 + s4);
        w.x = s4 + 0 <= t ? w.x : 0.f; w.y = s4 + 1 <= t ? w.y : 0.f; w.z = s4 + 2 <= t ? w.z : 0.f; w.w = s4 + 3 <= t ? w.w : 0.f;
        *(LAS unsigned long long*)(wT + t * PITCH + s4) = (unsigned long long)pk2(w.x, w.y) | ((unsigned long long)pk2(w.z, w.w) << 32); }
    for (int ci = F.vcu >> 3; ci < 128 + 32; ci += (F.G >> 3)) { const int L = ci < 128 ? 128 : 64; const int row0 = ci < 128 ? ci * 128 : MP + (ci - 128) * 64;
        { const int c8 = (tid & 15) * 8;
          const GAS f32x4* gp = (const GAS f32x4*)(INP(I_SGG) + g * 128 + c8); const GAS f32x4* bp = (const GAS f32x4*)(INP(I_SGB) + g * 128 + c8); const f32x4 g0 = gp[0], g1 = gp[1], b0 = bp[0], b1 = bp[1];
          for (int s = (tid >> 4) * 2; s < L; s += 64) {
            float v[2][8];
#pragma unroll
            for (int k2 = 0; k2 < 2; ++k2) { const int row = row0 + s + k2; unpack8(*(const GAS v4u*)(VN + (size_t)row * D + g * 128 + c8), v[k2]);
                const pg8::f32x2 sq2 = *(const GAS pg8::f32x2*)(STV + 2 * (size_t)row); const float mu = sq2.x * (1.0f / D); const float rstd = 1.0f / sqrtf(fmaxf(sq2.y * (1.0f / D) - mu * mu, 0.f) + LN_EPS);
#pragma unroll
                for (int i = 0; i < 4; ++i) { v[k2][i] = (v[k2][i] - mu) * rstd * g0[i] + b0[i]; v[k2][4 + i] = (v[k2][4 + i] - mu) * rstd * g1[i] + b1[i]; }
                if (row >= MP) { GAS f32x4* op = (GAS f32x4*)(F.out + O_SGV + (size_t)(row - MP) * D + g * 128 + c8); op[0] = (f32x4){v[k2][0], v[k2][1], v[k2][2], v[k2][3]}; op[1] = (f32x4){v[k2][4], v[k2][5], v[k2][6], v[k2][7]}; } }
#pragma unroll
            for (int i = 0; i < 8; ++i) *(LAS unsigned*)(vT + (c8 + i) * PITCH + s) = pk2(v[0][i], v[1][i]); } }
        __syncthreads();
        bf16x8 af[4];
#pragma unroll
        for (int ks = 0; ks < 4; ++ks) af[ks] = (ks * 32 < L) ? *(const LAS bf16x8*)(vT + (16 * wid + fr) * PITCH + ks * 32 + fq * 8) : (bf16x8){0, 0, 0, 0, 0, 0, 0, 0};
        unsigned long long uu8[8]; float bs8[8];
#pragma unroll
        for (int j = 0; j < 8; ++j) if (16 * j < L) { const int t = 16 * j + fr; bs8[j] = INP(I_SGBIAS)[g * 128 + t]; uu8[j] = *(const GAS unsigned long long*)(U + (size_t)(row0 + t) * D + g * 128 + 16 * wid + 4 * fq); }
#pragma unroll
        for (int j = 0; j < 8; ++j) if (16 * j < L) { f32x4 acc = {0.f, 0.f, 0.f, 0.f}; const int nk = ((16 * j + 15) >> 5) + 1;
#pragma unroll
            for (int ks = 0; ks < 4; ++ks) if (ks < nk) { const bf16x8 bfr = *(const LAS bf16x8*)(wT + (16 * j + fr) * PITCH + ks * 32 + fq * 8); acc = __builtin_amdgcn_mfma_f32_16x16x32_bf16(af[ks], bfr, acc, 0, 0, 0); }
            const int t = 16 * j + fr; const float bs = bs8[j]; const size_t o = (size_t)(row0 + t) * D + g * 128 + 16 * wid + 4 * fq;
            const unsigned long long uu = uu8[j]; const unsigned ulo = (unsigned)uu, uhi = (unsigned)(uu >> 32);
            const float r0 = __builtin_bit_cast(float, ulo << 16) * (acc[0] + bs), r1 = __builtin_bit_cast(float, ulo & 0xffff0000u) * (acc[1] + bs), r2 = __builtin_bit_cast(float, uhi << 16) * (acc[2] + bs), r3 = __builtin_bit_cast(float, uhi & 0xffff0000u) * (acc[3] + bs);
            *(GAS unsigned long long*)(G + o) = (unsigned long long)pk2(r0, r1) | ((unsigned long long)pk2(r2, r3) << 32); }
        __syncthreads(); }
}
#ifndef MK_N_LAUNCHES
#define MK_N_LAUNCHES 1
#endif
constexpr int PER_PHASE = 19;
constexpr int N_LAUNCHES = MK_N_LAUNCHES;
__device__ __attribute__((aligned(16))) unsigned g_bar_words[XCD_BAR_WORDS + 64];
struct Args { const float* in[32]; float* out; unsigned char* ws; int ph_lo, ph_hi, li, pad; };
static_assert(sizeof(Args) == 32 * 8 + 8 + 8 + 16, "Args has no padding bytes");

__global__ void __launch_bounds__(NWAVES * 64, 2) fwd_kernel(Args args) {
    extern __shared__ __attribute__((aligned(16))) unsigned char lds[];
    Frame F;
    F.lds = (LAS unsigned char*)lds;
    F.MISC = (volatile LAS unsigned*)(F.lds + MISC_OFF);
    F.wave = __builtin_amdgcn_readfirstlane((int)threadIdx.x >> 6);
    F.G = gridDim.x; { const int bx = blockIdx.x; F.vcu = (F.G % 8 == 0) ? (bx % 8) * (F.G / 8) + bx / 8 : bx; }
    F.out = args.out; F.ws = args.ws; F.ctl = (gu32*)(args.ws + WS_CTL);
    unsigned char* ws = args.ws;
    for (int u = ftid(F); u < (LDS_BYTES - LDSCTL_OFF) / 4; u += NWAVES * 64) ((LAS unsigned*)(F.lds + LDSCTL_OFF))[u] = 0u;
    __syncthreads();
    XcdBarrier bar; bar.bar = g_bar_words; bar.x = 0; bar.st = nullptr; bar.wave = 1;
    if (N_LAUNCHES != PER_PHASE) bar = xcd_barrier_post(g_bar_words, F.MISC + 8, F.wave);
#define GRID_BAR(seam) do { if (N_LAUNCHES == PER_PHASE) { if (ftid(F) == 0) __hip_atomic_store(F.ctl + CW_TMO, 0xBADBA0u | (unsigned)(seam), RLX_AGENT); } else { xcd_barrier(bar); } } while (0)
    const int lo = args.ph_lo, hi = args.ph_hi;
#define IN(k) (lo <= (k) && (k) < hi)
#define SEAM(k) do { if (IN(k) && IN((k) + 1)) GRID_BAR(k); } while (0)
#define RUN(k, ...) if (IN(k)) { { __VA_ARGS__ } SEAM(k); }
    bf16* XA = (bf16*)(ws + WS_XA); float* XR = (float*)(ws + WS_XR); bf16* ACT = (bf16*)(ws + WS_ACT);
    float* out = args.out;
    const int cblk = (int)blockIdx.x;

    float* const ST0 = (float*)(F.ctl + CW_STAT); float* const ST1 = ST0 + (size_t)M * 2; float* const ST2 = ST1 + (size_t)M * 2;
    const float* const GV = (const float*)(ws + WS_GBV); const float* const BV = GV + NVEC;
    RUN(0, p0_prologue(F);)
    RUN(1, pg8::Gemm g{XA, (const bf16*)(ws + WS_WINE), M, NE, D}; pg8::StaticOrder S; S.init(M, NE, F.G, cblk);
        pg8::EpiInE E{(bf16*)(ws + WS_Q), (bf16*)(ws + WS_K), (bf16*)(ws + WS_V), (bf16*)(ws + WS_XB), (bf16*)(ws + WS_GB), out + O_KP, out + O_VP, out + O_KS, out + O_VS, out + O_RCP, out + O_RCS, QSCALE};
        pg8::gemm_phase<pg8::EpiInE, pg8::StaticOrder, true, true>(F.lds + RING_OFF, g, S, E, F.wave);
        if (F.G == 256 && cblk >= 208) { p2_scans(F, (cblk - 208) * NWAVES + F.wave, 48 * NWAVES); p2_vecs(F, VEC_UP0, VEC_UP0 + FF2, (cblk - 208) * 512 + ftid(F), 48 * 512); }
        else if (F.G != 256) { p2_scans(F, F.vcu * NWAVES + F.wave, F.G * NWAVES); p2_vecs(F, 0, NVEC, F.vcu * 512 + ftid(F), F.G * 512); })
    RUN(2, p2_norms(F); for (int it = F.vcu * NWAVES + F.wave; it < 2048; it += F.G * NWAVES) rg_wave_item(F, it, 1); __syncthreads();)
    RUN(3, p3_mixer(F);)
    RUN(4, pg8::Gemm g{(const bf16*)(ws + WS_MIX), (const bf16*)(ws + WS_WOUTE), MP, D, D}; pg8::StaticOrder S; S.init(MP, D, F.G, cblk);
        pg8::EpiRes<0, false> E{INP(I_XP), INP(I_XS), XA, nullptr, nullptr, nullptr, ST0};
        pg8::gemm_phase<pg8::EpiRes<0, false>, pg8::StaticOrder, true, true>(F.lds + RING_OFF, g, S, E, F.wave);
        for (int mu_ = cblk; mu_ < 256; mu_ += F.G) mini_seam<0, false>(F, (const bf16*)(ws + WS_MIX), (const bf16*)(ws + WS_WOUTE), D, mu_, INP(I_XS), XA, nullptr, nullptr, nullptr, ST0);
        )
    RUN(6, pg8::Gemm g{XA - 2 * D, (const bf16*)(ws + WS_WUP0), 73 * 256, FF2, D, 254}; pg8::StaticOrder S; S.init(73 * 256, FF2, F.G, cblk);
        pg8::EpiUpGate E{ACT, out + O_FCP, out + O_FCS, ST0, GV + VEC_UP0, BV + VEC_UP0, INP(I_FCW), INP(I_FCB), INP(I_SFC), (LAS float*)(F.lds + LDSX_OFF)};
        pg8::gemm_phase<pg8::EpiUpGate, pg8::StaticOrder, true, true>(F.lds + RING_OFF, g, S, E, F.wave);
        if (F.G == 256 && cblk >= 70) { weights_set(F, 1, (cblk - 70) * NWAVES + F.wave, 186 * NWAVES); weights_set(F, 2, (cblk - 70) * NWAVES + F.wave, 186 * NWAVES); })
    RUN(8, pg8::Gemm g{ACT, (const bf16*)(ws + WS_WDN0), MP, D, FF}; pg8::StaticOrder S; S.init(MP, D, F.G, cblk);
        stage_gb(F, INP(I_LMG), INP(I_LMB)); pg8::EpiRes<1, false> E{nullptr, nullptr, XA, nullptr, ST0, (const LAS float*)(F.lds + LDSX_OFF), ST1};
        pg8::gemm_phase<pg8::EpiRes<1, false>, pg8::StaticOrder, true, true>(F.lds + RING_OFF, g, S, E, F.wave);
        for (int mu_ = cblk; mu_ < 256; mu_ += F.G) mini_seam<1, false>(F, ACT, (const bf16*)(ws + WS_WDN0), FF, mu_, nullptr, XA, nullptr, ST0, (const LAS float*)(F.lds + LDSX_OFF), ST1);
        if (F.G == 256) { p2_vecs(F, VEC_INO, VEC_INO + 2 * D, F.vcu * 512 + ftid(F), F.G * 512); p2_vecs(F, VEC_UP1, VEC_UP1 + FF2, F.vcu * 512 + ftid(F), F.G * 512); })
    RUN(10, pg8::Gemm g{XA, (const bf16*)(ws + WS_WINO), MP, 2 * D, D}; pg8::StaticOrder S; S.init(MP, 2 * D, F.G, cblk); pg8::EpiInO E{(bf16*)(ws + WS_U), (bf16*)(ws + WS_VN), ST1, GV + VEC_INO, BV + VEC_INO, ST2 + (size_t)M * 2};
        pg8::gemm_phase<pg8::EpiInO, pg8::StaticOrder, true, true>(F.lds + RING_OFF, g, S, E, F.wave);
        for (int mu_ = cblk; mu_ < 512; mu_ += F.G) mini_ino(F, XA, (const bf16*)(ws + WS_WINO), mu_, (bf16*)(ws + WS_U), (bf16*)(ws + WS_VN), ST1, GV + VEC_INO, BV + VEC_INO, ST2 + (size_t)M * 2);)
    RUN(12, sgu_phase(F);)
    RUN(13, pg8::Gemm g{(const bf16*)(ws + WS_G), (const bf16*)(ws + WS_WOUTO), MP, D, D}; pg8::StaticOrder S; S.init(MP, D, F.G, cblk);
        stage_gb(F, INP(I_LFG), INP(I_LFB)); pg8::EpiRes<1, false> E{nullptr, nullptr, XA, nullptr, ST1, (const LAS float*)(F.lds + LDSX_OFF), ST2};
        pg8::gemm_phase<pg8::EpiRes<1, false>, pg8::StaticOrder, true, true>(F.lds + RING_OFF, g, S, E, F.wave);
        for (int mu_ = cblk; mu_ < 256; mu_ += F.G) mini_seam<1, false>(F, (const bf16*)(ws + WS_G), (const bf16*)(ws + WS_WOUTO), D, mu_, nullptr, XA, nullptr, ST1, (const LAS float*)(F.lds + LDSX_OFF), ST2);
        )
    RUN(15, pg8::Gemm g{XA - 2 * D, (const bf16*)(ws + WS_WUP1), 73 * 256, FF2, D, 254}; pg8::StaticOrder S; S.init(73 * 256, FF2, F.G, cblk);
        pg8::EpiUpGate E{ACT, out + O_FCP + (size_t)NBP * 2 * FF2, out + O_FCS + (size_t)NBS * 2 * FF2, ST2, GV + VEC_UP1, BV + VEC_UP1, INP(I_FCW) + 3 * FF2, INP(I_FCB) + FF2, INP(I_SFC) + (size_t)NBS * 2 * FF2, (LAS float*)(F.lds + LDSX_OFF)};
        pg8::gemm_phase<pg8::EpiUpGate, pg8::StaticOrder, true, true>(F.lds + RING_OFF, g, S, E, F.wave);)
    RUN(17, pg8::Gemm g{ACT, (const bf16*)(ws + WS_WDN1), MP, D, FF}; pg8::StaticOrder S; S.init(MP, D, F.G, cblk);
        stage_gb(F, INP(I_LMG) + D, INP(I_LMB) + D); pg8::EpiRes<1, true> E{nullptr, nullptr, XA, XR, ST2, (const LAS float*)(F.lds + LDSX_OFF), nullptr};
        pg8::gemm_phase<pg8::EpiRes<1, true>, pg8::StaticOrder, true, true>(F.lds + RING_OFF, g, S, E, F.wave);
        for (int mu_ = cblk; mu_ < 256; mu_ += F.G) mini_seam<1, true>(F, ACT, (const bf16*)(ws + WS_WDN1), FF, mu_, nullptr, XA, XR, ST2, (const LAS float*)(F.lds + LDSX_OFF), nullptr);)
    if (IN(18)) { final_ln_phase(F, XR, INP(I_LFG) + D, INP(I_LFB) + D); }
    if (N_LAUNCHES != PER_PHASE) {
        __syncthreads();
        if (ftid(F) == 0) { const unsigned done = __hip_atomic_fetch_add(g_bar_words + XCD_BAR_WORDS, 1u, __ATOMIC_RELAXED, __HIP_MEMORY_SCOPE_AGENT); F.MISC[12] = (done + 1u == (unsigned)F.G) ? 1u : 0u; }
        __syncthreads();
        if (F.MISC[12] != 0u) { for (int i = ftid(F); i < (XCD_BAR_WORDS + 64) / 4; i += NWAVES * 64) ((GAS v4u*)g_bar_words)[i] = (v4u){0u, 0u, 0u, 0u}; }
    }
#undef IN
#undef SEAM
}

extern "C" void kernel_launch(void* const* d_in, const int* in_sizes, int n_in, void* d_out, int out_size, void* d_ws, size_t ws_size, hipStream_t stream) {
    static int grid = 0;
    if (grid == 0) {
        if (n_in != N_IN || (size_t)out_size != O_END || ws_size < WS_END) { fprintf(stderr, "kernel_launch: built for %d inputs, %zu outputs, >= %zu bytes of workspace; got n_in %d, out %d, ws %zu; nothing launched\n", (int)N_IN, (size_t)O_END, (size_t)WS_END, n_in, out_size, ws_size); grid = -1; return; }
        int dev = 0, cus = 0, per_cu = 0;
        if (hipGetDevice(&dev) != hipSuccess || hipDeviceGetAttribute(&cus, hipDeviceAttributeMultiprocessorCount, dev) != hipSuccess) { fprintf(stderr, "kernel_launch: device query failed\n"); grid = -1; return; }
        if (hipFuncSetAttribute((const void*)fwd_kernel, hipFuncAttributeMaxDynamicSharedMemorySize, LDS_BYTES) != hipSuccess) { fprintf(stderr, "kernel_launch: hipFuncSetAttribute failed\n"); grid = -1; return; }
        if (hipOccupancyMaxActiveBlocksPerMultiprocessor(&per_cu, (const void*)fwd_kernel, NWAVES * 64, LDS_BYTES) != hipSuccess || per_cu < 1)
            fprintf(stderr, "kernel_launch: note: occupancy query reports %d workgroups per CU\n", per_cu);
        (void)hipGetLastError();
        grid = cus;
    }
    if (grid < 0) return;
    if (N_LAUNCHES == PER_PHASE) { if (hipMemsetAsync((char*)d_ws + WS_CTL, 0, 32768, stream) != hipSuccess) { fprintf(stderr, "kernel_launch: hipMemsetAsync failed\n"); return; } }
    Args a{};
    for (int i = 0; i < 32; ++i) a.in[i] = (const float*)d_in[i];
    a.out = (float*)d_out; a.ws = (unsigned char*)d_ws;
    for (int li = 0; li < N_LAUNCHES; ++li) {
        a.ph_lo = (N_LAUNCHES == PER_PHASE) ? li : 0; a.ph_hi = (N_LAUNCHES == PER_PHASE) ? li + 1 : PER_PHASE; a.li = li;
        hipLaunchKernelGGL(fwd_kernel, dim3(grid), dim3(NWAVES * 64), LDS_BYTES, stream, a);
        const hipError_t le = hipPeekAtLastError();
        if (le != hipSuccess) { fprintf(stderr, "kernel_launch: launch %d failed: %s\n", li, hipGetErrorName(le)); break; }
    }
}
```

```cpp
#include <hip/hip_runtime.h>
#include <cstdio>
#include <cstdint>
#include <cmath>
namespace pg8 {
#define PG8_LAS __attribute__((address_space(3)))
typedef unsigned short bf16_t;
typedef short bf16x8 __attribute__((ext_vector_type(8)));
typedef float f32x4 __attribute__((ext_vector_type(4)));
typedef unsigned u32x4 __attribute__((ext_vector_type(4)));
constexpr int BM = 256, BK = 64, HALF = 128, HTB = HALF * BK * 2  , STAGE_BYTES = 8 * HTB, NXCD = 8, WGM = 8;

__host__ __device__ __forceinline__ int lds_byte(int r, int c) { const int st = (r >> 4) * 2 + (c >> 5), rr = r & 15, cc = c & 31, ob = rr * 64 + cc * 2; return st * 1024 + (ob ^ (((ob >> 9) & 1) << 5)); }
__host__ __device__ __forceinline__ void stage_rc(int b, int& R, int& C) { const int st = b / 1024, sb = b % 1024, swz = sb ^ (((sb >> 9) & 1) << 5); R = (st >> 1) * 16 + swz / 64; C = (st & 1) * 32 + (swz % 64) / 2; }
__host__ __device__ __forceinline__ int perm32(int rho) { const int n = rho >> 4, i = rho & 15; return 8 * (i >> 2) + 4 * n + (i & 3); }

struct Unit { int pm, pn; };
struct Gemm { const bf16_t* A; const bf16_t* Bt; int M, N, K; int a_step_rows = 256; };

struct StaticOrder {
    int nM, nN, nwg, G, c, wgm;
    __host__ __device__ void init(int M, int N, int G_, int c_, int wgm_ = WGM) { nM = M / BM; nN = N / BM; nwg = nM * nN; G = G_; c = c_; wgm = wgm_; }
    __host__ __device__ bool next(int i, Unit& u) const { return at((long)i * G + c, u); }
    __host__ __device__ bool at(long L, Unit& u) const {
        if (L < 0 || L >= nwg) return false;
        int wgid = (int)L; { const int q = nwg / NXCD, r = nwg % NXCD, xcd = wgid % NXCD, off = wgid / NXCD; wgid = (xcd < r ? xcd * (q + 1) : r * (q + 1) + (xcd - r) * q) + off; }
        const int nig = wgm * nN, gid = wgid / nig, fm = gid * wgm, gsz = (nM - fm) < wgm ? (nM - fm) : wgm;
        u.pm = fm + ((wgid % nig) % gsz); u.pn = (wgid % nig) / gsz; return true;
    }
    __device__ __forceinline__ void a_ready(const Unit&) const {}
    __device__ __forceinline__ void done(const Unit&) const {}
};
__device__ __forceinline__ unsigned cvt_pk_bf16(float lo, float hi) { unsigned r; asm volatile("v_cvt_pk_bf16_f32 %0, %1, %2" : "=v"(r) : "v"(lo), "v"(hi)); return r; }
typedef float f32x2 __attribute__((ext_vector_type(2)));
__device__ __forceinline__ float gelu_tanh(float x) {
    const float y = x * (1.0f + 0.044715f * x * x);
    const float e = __builtin_amdgcn_exp2f(-2.302208198f * y);
    return x * __builtin_amdgcn_rcpf(1.0f + e);
}
__device__ __forceinline__ void st_bf16x8(bf16_t* p, f32x4 v0, f32x4 v1) {
    u32x4 w; w.x = cvt_pk_bf16(v0[0], v0[1]); w.y = cvt_pk_bf16(v0[2], v0[3]); w.z = cvt_pk_bf16(v1[0], v1[1]); w.w = cvt_pk_bf16(v1[2], v1[3]); *(u32x4*)p = w;
}
__device__ __forceinline__ void st_f32x8(float* p, f32x4 v0, f32x4 v1) { *(f32x4*)p = v0; *(f32x4*)(p + 4) = v1; }
__device__ __forceinline__ void st_f32x8_nt(float* p, f32x4 v0, f32x4 v1) { __builtin_nontemporal_store(v0, (f32x4*)p); __builtin_nontemporal_store(v1, (f32x4*)(p + 4)); }
__device__ __forceinline__ f32x2 gelu_tanh2(f32x2 v) {
    const f32x2 p = (v * v) * 0.044715f + 1.0f; const f32x2 a = (v * p) * (-2.302208198f);
    f32x2 ex; ex.x = __builtin_amdgcn_exp2f(a.x); ex.y = __builtin_amdgcn_exp2f(a.y);
    const f32x2 d = ex + 1.0f; f32x2 r; r.x = __builtin_amdgcn_rcpf(d.x); r.y = __builtin_amdgcn_rcpf(d.y);
    return v * r;
}
__device__ __forceinline__ f32x4 gelu4(f32x4 v) { const f32x2 a = gelu_tanh2((f32x2){v[0], v[1]}), b = gelu_tanh2((f32x2){v[2], v[3]}); return (f32x4){a.x, a.y, b.x, b.y}; }

constexpr int E_MP = 16384;

struct EpiInE {
    static constexpr bool PERM = true, AFTER_DRAIN = false;
    bf16_t *Q, *K, *V, *XB, *GB;
    float *okp, *ovp, *oks, *ovs, *orcp, *orcs;
    float qscale;
    __device__ __forceinline__ void operator()(const f32x4 (&acc)[2][2][4][2], const Unit& u, int wr, int wc, int fr, int fq) const {
        const int seg = u.pn >> 1; const int cb0 = (u.pn & 1) * 256 + wc * 32 + 8 * fq; const bool prm = u.pm < 64;
#pragma unroll
        for (int ai = 0; ai < 2; ++ai)
#pragma unroll
            for (int m = 0; m < 4; ++m) { const int row = u.pm * BM + ai * HALF + wr * 64 + m * 16 + fr;
#pragma unroll
                for (int bj = 0; bj < 2; ++bj) { const int c = cb0 + bj * HALF; const f32x4 v0 = acc[ai][bj][m][0], v1 = acc[ai][bj][m][1]; const size_t o = (size_t)row * 512 + c;
                    if (seg == 0) { st_bf16x8(Q + o, v0 * qscale, v1 * qscale); }
                    else if (seg == 1) { st_bf16x8(K + o, v0, v1); st_f32x8_nt(prm ? okp + o : oks + (o - (size_t)E_MP * 512), v0, v1); }
                    else if (seg == 2) { st_bf16x8(V + o, v0, v1); st_f32x8_nt(prm ? ovp + o : ovs + (o - (size_t)E_MP * 512), v0, v1); }
                    else if (seg == 3) { st_bf16x8(XB + o, v0, v1);
                        if (prm) { const int t = row & 4095; if (t >= 4093) st_f32x8(orcp + ((size_t)(row >> 12) * 3 + (t - 4093)) * 512 + c, v0, v1); }
                        else { const int rs = row - E_MP, t = rs & 63; if (t >= 61) st_f32x8(orcs + ((size_t)(rs >> 6) * 3 + (t - 61)) * 512 + c, v0, v1); } }
                    else { st_bf16x8(GB + o, gelu4(v0), gelu4(v1)); } } }
    }
};
__device__ __forceinline__ void row_stats(const float* st, int row, float& mu, float& rstd) {
    const f32x2 sq = *(const f32x2*)(st + 2 * (size_t)row); const float s = sq.x, q = sq.y;
    mu = s * (1.0f / 1024.0f); const float var = fmaxf(q * (1.0f / 1024.0f) - mu * mu, 0.f); rstd = 1.0f / sqrtf(var + 1e-5f);
}
__device__ __forceinline__ f32x4 bf16lo4(unsigned a, unsigned b) { return (f32x4){__builtin_bit_cast(float, a << 16), __builtin_bit_cast(float, a & 0xffff0000u), __builtin_bit_cast(float, b << 16), __builtin_bit_cast(float, b & 0xffff0000u)}; }
template <int MODE, bool OUT32> struct EpiRes {
    static constexpr bool PERM = true, AFTER_DRAIN = false;
    const float *xp, *xs;
    bf16_t* ZA; float* Z32;
    const float* st_in; const PG8_LAS float* gb_lds;
    float* st_out;
    __device__ __forceinline__ void operator()(const f32x4 (&acc)[2][2][4][2], const Unit& u, int wr, int wc, int fr, int fq) const {
        const int c0 = u.pn * BM + wc * 32 + 8 * fq; const float alpha = 1.41421356237309505f;
        constexpr int NB = MODE == 0 ? 2 : 4;
#pragma unroll
        for (int ai = 0; ai < 2; ++ai)
#pragma unroll
        for (int mh = 0; mh < 4 / NB; ++mh) {
            f32x4 rf[MODE == 0 ? NB : 1][2][2]; u32x4 rb[MODE != 0 ? NB : 1][2]; f32x2 sq[NB];
#pragma unroll
            for (int mm = 0; mm < NB; ++mm) { const int m = NB * mh + mm; const int row = u.pm * BM + ai * HALF + wr * 64 + m * 16 + fr;
                if (MODE == 1) sq[mm] = *(const f32x2*)(st_in + 2 * (size_t)row);
#pragma unroll
                for (int bj = 0; bj < 2; ++bj) { const size_t o = (size_t)row * 1024 + c0 + bj * HALF;
                    if (MODE == 0) { const float* src = row < E_MP ? xp + o : xs + (o - (size_t)E_MP * 1024); rf[mm][bj][0] = *(const f32x4*)src; rf[mm][bj][1] = *(const f32x4*)(src + 4); }
                    else rb[mm][bj] = *(const u32x4*)(ZA + o); } }
            asm volatile("" ::: "memory");
            float ss[NB], qq[NB];
#pragma unroll
            for (int mm = 0; mm < NB; ++mm) { const int m = NB * mh + mm; const int row = u.pm * BM + ai * HALF + wr * 64 + m * 16 + fr;
                float mu = 0.f, rstd = 1.f; if (MODE == 1) { mu = sq[mm].x * (1.0f / 1024.0f); const float var = fmaxf(sq[mm].y * (1.0f / 1024.0f) - mu * mu, 0.f); rstd = 1.0f / sqrtf(var + 1e-5f); }
                float s = 0.f, q = 0.f;
#pragma unroll
                for (int bj = 0; bj < 2; ++bj) { const size_t o = (size_t)row * 1024 + c0 + bj * HALF; f32x4 r0, r1;
                    if (MODE == 0) { r0 = rf[mm][bj][0]; r1 = rf[mm][bj][1]; }
                    else if (MODE == 2) { r0 = bf16lo4(rb[mm][bj].x, rb[mm][bj].y); r1 = bf16lo4(rb[mm][bj].z, rb[mm][bj].w); }
                    else { const PG8_LAS f32x4* gp = (const PG8_LAS f32x4*)(gb_lds + c0 + bj * HALF); const PG8_LAS f32x4* bp = (const PG8_LAS f32x4*)(gb_lds + 1024 + c0 + bj * HALF);
                        r0 = (bf16lo4(rb[mm][bj].x, rb[mm][bj].y) - mu) * rstd * gp[0] + bp[0]; r1 = (bf16lo4(rb[mm][bj].z, rb[mm][bj].w) - mu) * rstd * gp[1] + bp[1]; }
                    const f32x4 z0 = r0 * alpha + acc[ai][bj][m][0], z1 = r1 * alpha + acc[ai][bj][m][1];
                    if (OUT32) st_f32x8(Z32 + o, z0, z1); else st_bf16x8(ZA + o, z0, z1);
                    s += (z0[0] + z0[1]) + (z0[2] + z0[3]) + (z1[0] + z1[1]) + (z1[2] + z1[3]);
                    q += (z0[0] * z0[0] + z0[1] * z0[1]) + (z0[2] * z0[2] + z0[3] * z0[3]) + (z1[0] * z1[0] + z1[1] * z1[1]) + (z1[2] * z1[2] + z1[3] * z1[3]); }
                s += __shfl_xor(s, 16); s += __shfl_xor(s, 32); q += __shfl_xor(q, 16); q += __shfl_xor(q, 32); ss[mm] = s; qq[mm] = q; }
            asm volatile("" ::: "memory");
            if (st_out && fq == 0) {
#pragma unroll
                for (int mm = 0; mm < NB; ++mm) { const size_t row = (size_t)(u.pm * BM + ai * HALF + wr * 64 + (NB * mh + mm) * 16 + fr); atomicAdd(st_out + 2 * row, ss[mm]); atomicAdd(st_out + 2 * row + 1, qq[mm]); } }
            asm volatile("" ::: "memory");
        }
    }
};
__device__ __forceinline__ float dpp_ror1(float x) { return __builtin_bit_cast(float, __builtin_amdgcn_update_dpp(0, __builtin_bit_cast(int, x), 0x121, 0xF, 0xF, false)); }
__device__ __forceinline__ float dpp_ror2(float x) { return __builtin_bit_cast(float, __builtin_amdgcn_update_dpp(0, __builtin_bit_cast(int, x), 0x122, 0xF, 0xF, false)); }
constexpr int E_M = 18432, E_FF = 2816, E_FF2 = 5632;
struct EpiUpGate {
    static constexpr bool PERM = true, AFTER_DRAIN = false;
    bf16_t* ACT; float *ofcp, *ofcs;
    const float *st, *G, *B;
    const float *cw, *cb, *sfc;
    PG8_LAS float* xch;
    __device__ __forceinline__ void operator()(f32x4 (&acc)[2][2][4][2], const Unit& u, int wr, int wc, int fr, int fq) const {
        const int lc0 = wc * 32 + 8 * fq;
        const int R0 = 254 * u.pm - 2 + wr * 64 + fr;
        { f32x4 gq[2][2], bq[2][2];
#pragma unroll
          for (int bj = 0; bj < 2; ++bj)
#pragma unroll
              for (int n = 0; n < 2; ++n) { gq[bj][n] = *(const f32x4*)(G + u.pn * BM + bj * HALF + lc0 + 4 * n); bq[bj][n] = *(const f32x4*)(B + u.pn * BM + bj * HALF + lc0 + 4 * n); }
          f32x2 sq[2][4];
#pragma unroll
          for (int ai = 0; ai < 2; ++ai)
#pragma unroll
              for (int m = 0; m < 4; ++m) { int R = R0 + ai * HALF + m * 16; R = R < 0 ? 0 : (R >= E_M ? E_M - 1 : R); sq[ai][m] = *(const f32x2*)(st + 2 * (size_t)R); }
          asm volatile("" ::: "memory");
#pragma unroll
          for (int ai = 0; ai < 2; ++ai)
#pragma unroll
              for (int m = 0; m < 4; ++m) { const float mu = sq[ai][m].x * (1.0f / 1024.0f); const float rstd = 1.0f / sqrtf(fmaxf(sq[ai][m].y * (1.0f / 1024.0f) - mu * mu, 0.f) + 1e-5f);
#pragma unroll
                  for (int bj = 0; bj < 2; ++bj)
#pragma unroll
                      for (int n = 0; n < 2; ++n) acc[ai][bj][m][n] = (acc[ai][bj][m][n] - mu * gq[bj][n]) * rstd + bq[bj][n]; } }
#pragma unroll
        for (int ai = 0; ai < 2; ++ai)
#pragma unroll
            for (int m = 0; m < 4; ++m) { const int lr = ai * HALF + wr * 64 + m * 16 + fr, R = R0 + ai * HALF + m * 16;
                if (lr >= 2 && R < E_M) { float* dst = nullptr;
                    if (R < E_MP) { const int t = R & 4095; if (t >= 4094) dst = ofcp + ((size_t)(R >> 12) * 2 + (t - 4094)) * E_FF2; }
                    else { const int rs = R - E_MP, t = rs & 63; if (t >= 62) dst = ofcs + ((size_t)(rs >> 6) * 2 + (t - 62)) * E_FF2; }
                    if (dst) {
#pragma unroll
                        for (int bj = 0; bj < 2; ++bj) st_f32x8(dst + bj * E_FF + 128 * u.pn + lc0, acc[ai][bj][m][0], acc[ai][bj][m][1]); } } }
        if (fr >= 14) {
#pragma unroll
            for (int ai = 0; ai < 2; ++ai)
#pragma unroll
                for (int bj = 0; bj < 2; ++bj)
#pragma unroll
                    for (int n = 0; n < 2; ++n) *(PG8_LAS f32x4*)(xch + (((2 * ai + wr) * 2 + (fr - 14)) * 2 + bj) * 128 + lc0 + 4 * n) = acc[ai][bj][3][n]; }
        asm volatile("s_waitcnt lgkmcnt(0)" ::: "memory"); __builtin_amdgcn_s_barrier(); asm volatile("" ::: "memory");
        const int Rt0 = 254 * u.pm - 2, Rt1 = Rt0 + 255; const bool tile_has_start = Rt1 >= E_MP || ((Rt0 <= 0 ? 0 : ((Rt0 + 4095) & ~4095)) <= Rt1) || (((Rt0 <= 1 ? 1 : (((Rt0 - 1 + 4095) & ~4095) + 1))) <= Rt1);
        unsigned outp[2][4][2][2];
#pragma unroll
        for (int n = 0; n < 2; ++n) {
            const int gc = 128 * u.pn + lc0 + 4 * n;
            f32x4 w0[2], w1[2], w2[2], cbv[2];
#pragma unroll
            for (int bj = 0; bj < 2; ++bj) { w0[bj] = *(const f32x4*)(cw + gc + bj * E_FF); w1[bj] = *(const f32x4*)(cw + E_FF2 + gc + bj * E_FF); w2[bj] = *(const f32x4*)(cw + 2 * E_FF2 + gc + bj * E_FF); cbv[bj] = *(const f32x4*)(cb + gc + bj * E_FF); }
#pragma unroll
            for (int ai = 0; ai < 2; ++ai)
#pragma unroll
                for (int m = 0; m < 4; ++m) { const int R = R0 + ai * HALF + m * 16; const int blk = 2 * ai + wr;
                    int t; bool samp; if (R < E_MP) { t = R & 4095; samp = false; } else { t = (R - E_MP) & 63; samp = true; }
                    f32x4 y[2];
#pragma unroll
                    for (int bj = 0; bj < 2; ++bj) { const f32x4 cur = acc[ai][bj][m][n]; f32x4 prev;
                        if (m > 0) prev = acc[ai][bj][m - 1][n];
                        else if (blk > 0) prev = *(const PG8_LAS f32x4*)(xch + (((blk - 1) * 2 + (fr & 1)) * 2 + bj) * 128 + lc0 + 4 * n);
                        else prev = (f32x4){0.f, 0.f, 0.f, 0.f};
                        f32x4 p1, p2;
#pragma unroll
                        for (int e_ = 0; e_ < 4; ++e_) { p1[e_] = dpp_ror1(fr == 15 ? prev[e_] : cur[e_]); p2[e_] = dpp_ror2(fr >= 14 ? prev[e_] : cur[e_]); }
                        if (tile_has_start && t < 2 && R >= 0 && R < E_M) {
                            f32x4 s0 = {0.f, 0.f, 0.f, 0.f}, s1 = {0.f, 0.f, 0.f, 0.f};
                            if (samp) { const float* sp = sfc + (size_t)((R - E_MP) >> 6) * 2 * E_FF2 + gc + bj * E_FF; s0 = *(const f32x4*)sp; s1 = *(const f32x4*)(sp + E_FF2); }
                            if (t == 0) { p1 = s1; p2 = s0; } else p2 = s1; }
                        y[bj] = cbv[bj] + w0[bj] * p2 + w1[bj] * p1 + w2[bj] * cur; }
                    const f32x4 gte = gelu4(y[0]) * y[1];
                    outp[ai][m][n][0] = cvt_pk_bf16(gte[0], gte[1]); outp[ai][m][n][1] = cvt_pk_bf16(gte[2], gte[3]); }
        }
#pragma unroll
        for (int ai = 0; ai < 2; ++ai)
#pragma unroll
            for (int m = 0; m < 4; ++m) { const int lr = ai * HALF + wr * 64 + m * 16 + fr, R = R0 + ai * HALF + m * 16;
                if (lr >= 2 && R < E_M) { u32x4 w; w.x = outp[ai][m][0][0]; w.y = outp[ai][m][0][1]; w.z = outp[ai][m][1][0]; w.w = outp[ai][m][1][1]; *(u32x4*)(ACT + (size_t)R * E_FF + 128 * u.pn + lc0) = w; } }
    }
};
struct EpiInO {
    static constexpr bool PERM = true, AFTER_DRAIN = false;
    bf16_t* U; bf16_t* VB; const float *st, *G, *B; float* stv;
    __device__ __forceinline__ void operator()(const f32x4 (&acc)[2][2][4][2], const Unit& u, int wr, int wc, int fr, int fq) const {
        const bool isu = u.pn < 4; const int c0 = (u.pn & 3) * BM + wc * 32 + 8 * fq; const int cg0 = u.pn * BM + wc * 32 + 8 * fq;
        f32x4 gq[2][2], bq[2][2];
#pragma unroll
        for (int bj = 0; bj < 2; ++bj)
#pragma unroll
            for (int n = 0; n < 2; ++n) { gq[bj][n] = *(const f32x4*)(G + cg0 + bj * HALF + 4 * n); bq[bj][n] = *(const f32x4*)(B + cg0 + bj * HALF + 4 * n); }
        f32x2 sqa[2][4];
#pragma unroll
        for (int ai = 0; ai < 2; ++ai)
#pragma unroll
            for (int m = 0; m < 4; ++m) sqa[ai][m] = *(const f32x2*)(st + 2 * (size_t)(u.pm * BM + ai * HALF + wr * 64 + m * 16 + fr));
        asm volatile("" ::: "memory");
#pragma unroll
        for (int ai = 0; ai < 2; ++ai) {
            const f32x2 (&sq)[4] = sqa[ai];
            float ss[4], qq[4];
#pragma unroll
            for (int m = 0; m < 4; ++m) { const int row = u.pm * BM + ai * HALF + wr * 64 + m * 16 + fr;
                const float mu = sq[m].x * (1.0f / 1024.0f); const float rstd = 1.0f / sqrtf(fmaxf(sq[m].y * (1.0f / 1024.0f) - mu * mu, 0.f) + 1e-5f);
                float s = 0.f, q = 0.f;
#pragma unroll
                for (int bj = 0; bj < 2; ++bj) { const size_t o = (size_t)row * 1024 + c0 + bj * HALF;
                    const f32x4 v0 = gelu4((acc[ai][bj][m][0] - mu * gq[bj][0]) * rstd + bq[bj][0]), v1 = gelu4((acc[ai][bj][m][1] - mu * gq[bj][1]) * rstd + bq[bj][1]);
                    st_bf16x8((isu ? U : VB) + o, v0, v1);
                    s += (v0[0] + v0[1]) + (v0[2] + v0[3]) + (v1[0] + v1[1]) + (v1[2] + v1[3]);
                    q += (v0[0] * v0[0] + v0[1] * v0[1]) + (v0[2] * v0[2] + v0[3] * v0[3]) + (v1[0] * v1[0] + v1[1] * v1[1]) + (v1[2] * v1[2] + v1[3] * v1[3]); }
                s += __shfl_xor(s, 16); s += __shfl_xor(s, 32); q += __shfl_xor(q, 16); q += __shfl_xor(q, 32); ss[m] = s; qq[m] = q; }
            asm volatile("" ::: "memory");
            if (!isu && fq == 0) {
#pragma unroll
                for (int m = 0; m < 4; ++m) { const size_t row = (size_t)(u.pm * BM + ai * HALF + wr * 64 + m * 16 + fr); atomicAdd(stv + 2 * row, ss[m]); atomicAdd(stv + 2 * row + 1, qq[m]); } }
            asm volatile("" ::: "memory");
        }
    }
};
template <class Epi, class Sched, bool ALIGN_EPI = false, bool SP2 = false>
__device__ __forceinline__ void gemm_phase(PG8_LAS unsigned char* lds, const Gemm g, const Sched& S, const Epi& E, const int wave_id) {
    int lane; asm volatile("v_mbcnt_lo_u32_b32 %0, -1, 0\n\tv_mbcnt_hi_u32_b32 %0, -1, %0" : "=v"(lane)); const int wid = wave_id, tid = wid * 64 + lane, wr = wid >> 2, wc = wid & 3, fr = lane & 15, fq = lane >> 4;
    const int K = g.K, nt = K / BK;
    unsigned voffA[2], voffB[2];
#pragma unroll
    for (int i = 0; i < 2; ++i) { int R, C; stage_rc(tid * 16 + i * 8192, R, C); const int Rb = Epi::PERM ? ((R & ~31) + perm32(R & 31)) : R;
        voffA[i] = (unsigned)(R * K + C) * 2u; voffB[i] = (unsigned)(Rb * K + C) * 2u; }
    const size_t kstep = (size_t)(BK * 2);
    const size_t hstep = (size_t)HALF * K * 2;
    const size_t tstep = 2 * hstep;
    const size_t tstepA = (size_t)g.a_step_rows * K * 2;
    const unsigned ldsw = (unsigned)wid * 1024u;
    const int aoff = lds_byte(wr * 64 + fr, fq * 8), boff = lds_byte(wc * 32 + fr, fq * 8);
#define PG8_SA(b, h) (((b) * 2 + (h)) * HTB)
#define PG8_SB(b, h) ((4 + (b) * 2 + (h)) * HTB)
#define PG8_STAGE(bufoff, gbase, voff) do { _Pragma("unroll") for (int _i = 0; _i < 2; ++_i) \
        __builtin_amdgcn_global_load_lds((const unsigned*)((const char*)(gbase) + (voff)[_i]), (PG8_LAS unsigned*)(lds + (bufoff) + ldsw + _i * 8192), 16, 0, 0); } while (0)
#define PG8_LDA(dst, b, h) do { _Pragma("unroll") for (int m = 0; m < 4; ++m) _Pragma("unroll") for (int k = 0; k < 2; ++k) dst[m][k] = *(const PG8_LAS bf16x8*)(lds + PG8_SA(b, h) + aoff + m * 2048 + k * 1024); } while (0)
#define PG8_LDB(dst, b, h) do { _Pragma("unroll") for (int n = 0; n < 2; ++n) _Pragma("unroll") for (int k = 0; k < 2; ++k) dst[n][k] = *(const PG8_LAS bf16x8*)(lds + PG8_SB(b, h) + boff + n * 2048 + k * 1024); } while (0)
#define PG8_MMA(ai, bj, At, Bt) do { __builtin_amdgcn_s_setprio(1); _Pragma("unroll") for (int m = 0; m < 4; ++m) _Pragma("unroll") for (int n = 0; n < 2; ++n) _Pragma("unroll") for (int k = 0; k < 2; ++k) \
        acc[ai][bj][m][n] = __builtin_amdgcn_mfma_f32_16x16x32_bf16(Bt[n][k], At[m][k], acc[ai][bj][m][n], 0, 0, 0); __builtin_amdgcn_s_setprio(0); } while (0)
#define PG8_WAIT_V(n) asm volatile("s_waitcnt vmcnt(" #n ")" ::: "memory")
#define PG8_WAIT_L(n) asm volatile("s_waitcnt lgkmcnt(" #n ")" ::: "memory")
#define PG8_BAR __builtin_amdgcn_s_barrier()
#define PG8_SCHED __builtin_amdgcn_sched_barrier(0)
    Unit cur, nxt; int ui = 0;
    if (!S.next(0, cur)) return;
    f32x4 acc[2][2][4][2];
#pragma unroll
    for (int a = 0; a < 2; ++a)
#pragma unroll
        for (int b = 0; b < 2; ++b)
#pragma unroll
            for (int m = 0; m < 4; ++m)
#pragma unroll
                for (int n = 0; n < 2; ++n) acc[a][b][m][n] = (f32x4){0.f, 0.f, 0.f, 0.f};
    bf16x8 At[4][2], B0[2][2], B1[2][2];
    const char* cA = (const char*)g.A + (size_t)cur.pm * tstepA; const char* cB = (const char*)g.Bt + (size_t)cur.pn * tstep;
    S.a_ready(cur);
    if constexpr (SP2) {
        PG8_STAGE(PG8_SB(0, 0), cB, voffB); PG8_STAGE(PG8_SB(0, 1), cB + hstep, voffB); PG8_STAGE(PG8_SA(0, 0), cA, voffA); PG8_STAGE(PG8_SA(0, 1), cA + hstep, voffA);
        if (wr == 1) PG8_BAR;
        PG8_WAIT_V(2); PG8_BAR;
        PG8_STAGE(PG8_SB(1, 0), cB + kstep, voffB); PG8_STAGE(PG8_SA(1, 0), cA + kstep, voffA); PG8_STAGE(PG8_SB(1, 1), cB + hstep + kstep, voffB);
        PG8_WAIT_V(6); PG8_BAR;
    } else {
        PG8_STAGE(PG8_SB(0, 0), cB, voffB); PG8_STAGE(PG8_SA(0, 0), cA, voffA); PG8_STAGE(PG8_SB(0, 1), cB + hstep, voffB); PG8_STAGE(PG8_SA(0, 1), cA + hstep, voffA);
        if (wr == 1) PG8_BAR;
        PG8_WAIT_V(4); PG8_BAR;
        PG8_STAGE(PG8_SB(1, 0), cB + kstep, voffB); PG8_STAGE(PG8_SA(1, 0), cA + kstep, voffA); PG8_STAGE(PG8_SB(1, 1), cB + hstep + kstep, voffB);
        PG8_WAIT_V(6); PG8_BAR;
    }
    for (;;) {
        const bool has_next = S.next(ui + 1, nxt);
        const char* nA = has_next ? (const char*)g.A + (size_t)nxt.pm * tstepA : cA; const char* nB = has_next ? (const char*)g.Bt + (size_t)nxt.pn * tstep : cB;
        for (int t = 0; t < nt; t += 2) {
            const bool last = (t == nt - 2);
            const char* a1 = cA + (size_t)(t + 1) * kstep;
            const char* a2 = last ? nA : cA + (size_t)(t + 2) * kstep; const char* b2 = last ? nB : cB + (size_t)(t + 2) * kstep;
            const char* a3 = a2 + kstep; const char* b3 = b2 + kstep;
            if (last && has_next) S.a_ready(nxt);
            if constexpr (SP2) {
            PG8_LDB(B0, 0, 0); PG8_LDB(B1, 0, 1); PG8_SCHED; PG8_LDA(At, 0, 0); PG8_STAGE(PG8_SA(1, 1), a1 + hstep, voffA);
            PG8_WAIT_V(8); PG8_WAIT_L(0); PG8_BAR; PG8_MMA(0, 0, At, B0); PG8_MMA(0, 1, At, B1); PG8_BAR; PG8_SCHED;
            PG8_LDA(At, 0, 1); PG8_STAGE(PG8_SB(0, 0), b2, voffB); PG8_STAGE(PG8_SB(0, 1), b2 + hstep, voffB); PG8_STAGE(PG8_SA(0, 0), a2, voffA);
            PG8_WAIT_V(8); PG8_WAIT_L(0); PG8_BAR; PG8_MMA(1, 0, At, B0); PG8_MMA(1, 1, At, B1); PG8_BAR; PG8_SCHED;
            PG8_LDB(B0, 1, 0); PG8_LDB(B1, 1, 1); PG8_SCHED; PG8_LDA(At, 1, 0); PG8_STAGE(PG8_SA(0, 1), a2 + hstep, voffA);
            PG8_WAIT_V(8); PG8_WAIT_L(0); PG8_BAR; PG8_MMA(0, 0, At, B0); PG8_MMA(0, 1, At, B1); PG8_BAR; PG8_SCHED;
            PG8_LDA(At, 1, 1); PG8_STAGE(PG8_SB(1, 0), b3, voffB); PG8_STAGE(PG8_SB(1, 1), b3 + hstep, voffB); PG8_STAGE(PG8_SA(1, 0), a3, voffA);
            PG8_WAIT_V(8); PG8_WAIT_L(0); PG8_BAR; PG8_MMA(1, 0, At, B0); PG8_MMA(1, 1, At, B1); PG8_BAR; PG8_SCHED;
            } else {
            PG8_LDB(B0, 0, 0); PG8_SCHED; PG8_LDA(At, 0, 0); PG8_STAGE(PG8_SA(1, 1), a1 + hstep, voffA);
            PG8_WAIT_L(8); PG8_BAR; PG8_WAIT_L(0); PG8_MMA(0, 0, At, B0); PG8_BAR; PG8_SCHED;
            PG8_LDB(B1, 0, 1); PG8_STAGE(PG8_SB(0, 0), b2, voffB);
            PG8_BAR; PG8_WAIT_L(0); PG8_MMA(0, 1, At, B1); PG8_BAR;
            PG8_LDA(At, 0, 1); PG8_STAGE(PG8_SA(0, 0), a2, voffA);
            PG8_BAR; PG8_WAIT_L(0); PG8_MMA(1, 0, At, B0); PG8_BAR; PG8_SCHED;
            PG8_STAGE(PG8_SB(0, 1), b2 + hstep, voffB);
            PG8_WAIT_V(6); PG8_BAR; PG8_MMA(1, 1, At, B1); PG8_BAR;
            PG8_LDB(B0, 1, 0); PG8_SCHED; PG8_LDA(At, 1, 0); PG8_STAGE(PG8_SA(0, 1), a2 + hstep, voffA);
            PG8_WAIT_L(8); PG8_BAR; PG8_WAIT_L(0); PG8_MMA(0, 0, At, B0); PG8_BAR; PG8_SCHED;
            PG8_LDB(B1, 1, 1); PG8_STAGE(PG8_SB(1, 0), b3, voffB);
            PG8_BAR; PG8_WAIT_L(0); PG8_MMA(0, 1, At, B1); PG8_BAR;
            PG8_LDA(At, 1, 1); PG8_STAGE(PG8_SA(1, 0), a3, voffA);
            PG8_BAR; PG8_WAIT_L(0); PG8_MMA(1, 0, At, B0); PG8_BAR; PG8_SCHED;
            PG8_STAGE(PG8_SB(1, 1), b3 + hstep, voffB);
            PG8_WAIT_V(6); PG8_BAR; PG8_MMA(1, 1, At, B1); PG8_BAR;
            }
        }
        if constexpr (ALIGN_EPI) { if (wr == 0) PG8_BAR; }
        if constexpr (!Epi::AFTER_DRAIN) { E(acc, cur, wr, wc, fr, fq); S.done(cur); }
        if (!has_next) break;
#pragma unroll
        for (int a = 0; a < 2; ++a)
#pragma unroll
            for (int b = 0; b < 2; ++b)
#pragma unroll
                for (int m = 0; m < 4; ++m)
#pragma unroll
                    for (int n = 0; n < 2; ++n) acc[a][b][m][n] = (f32x4){0.f, 0.f, 0.f, 0.f};
        cur = nxt; cA = nA; cB = nB; ++ui;
        if constexpr (ALIGN_EPI) { if (wr == 1) PG8_BAR; }
    }
    PG8_WAIT_V(0);
    if constexpr (!ALIGN_EPI) { if (wr == 0) PG8_BAR; }
    PG8_BAR;
    if constexpr (Epi::AFTER_DRAIN) { E.fused(acc, cur, wr, wc, fr, fq, lds, wid, lane); S.done(cur); }
#undef PG8_SA
#undef PG8_SB
#undef PG8_STAGE
#undef PG8_LDA
#undef PG8_LDB
#undef PG8_MMA
#undef PG8_WAIT_V
#undef PG8_WAIT_L
#undef PG8_BAR
#undef PG8_SCHED
}
}
#define GAS __attribute__((address_space(1)))
#define LAS __attribute__((address_space(3)))
typedef unsigned short bf16;
typedef unsigned v4u __attribute__((ext_vector_type(4)));
typedef float f32x4 __attribute__((ext_vector_type(4)));
typedef short bf16x8 __attribute__((ext_vector_type(8)));
typedef GAS unsigned gu32;
typedef GAS unsigned long long gu64;
#define RLX_AGENT __ATOMIC_RELAXED, __HIP_MEMORY_SCOPE_AGENT
#define LDS_WAIT() asm volatile("s_waitcnt lgkmcnt(0)" ::: "memory")
#define VM_WAIT() asm volatile("s_waitcnt vmcnt(0)" ::: "memory")
__device__ __forceinline__ unsigned long long rt() { return __builtin_amdgcn_s_memrealtime(); }
__device__ __forceinline__ unsigned f2bf(float f) { unsigned u = __builtin_bit_cast(unsigned, f); return (u + 0x7fffu + ((u >> 16) & 1u)) >> 16; }
__device__ __forceinline__ unsigned pk2(float lo, float hi) { return f2bf(lo) | (f2bf(hi) << 16); }

#define XB_TMO      128
#define XB_XCNT(j)  (256  + 64 * (j))
#define XB_XSUB(j)  (1280 + 64 * (j))
#define XB_XGEN(j)  (2304 + 64 * (j))
#define XB_TOP      3328
#define XB_TOPGEN   3392
#define XCD_BAR_WORDS 3456
#define XB_SPIN_CAP (1u << 18)

__device__ __forceinline__ unsigned xb_ld(unsigned* p)              { return __hip_atomic_load(p, __ATOMIC_RELAXED, __HIP_MEMORY_SCOPE_AGENT); }
__device__ __forceinline__ unsigned xb_add(unsigned* p, unsigned v) { return __hip_atomic_fetch_add(p, v, __ATOMIC_RELAXED, __HIP_MEMORY_SCOPE_AGENT); }
__device__ __forceinline__ unsigned xb_xcc_id() { return (unsigned)__builtin_amdgcn_s_getreg((3 << 11) | 20) & 0xFu; }
#define XB_SPIN(cond, bar) do { unsigned _sp = 0; while (cond) { __builtin_amdgcn_s_sleep(1); \
    if ((++_sp & 255u) == 0u) { if (xb_ld(&(bar)[XB_TMO])) break; if (_sp > XB_SPIN_CAP) { atomicAdd(&(bar)[XB_TMO], 1u); break; } } } } while (0)

struct XcdBarrier {
    unsigned* bar; unsigned x; int wave;
    volatile LAS unsigned* st;
};

__device__ __forceinline__ bool xb_lane0() { int r; asm volatile("v_mbcnt_lo_u32_b32 %0, -1, 0\n\tv_mbcnt_hi_u32_b32 %0, -1, %0" : "=v"(r)); return r == 0; }
#define XB_TID0(b) ((b).wave == 0 && xb_lane0())
__device__ __forceinline__ XcdBarrier xcd_barrier_post(unsigned* bar, volatile LAS unsigned* st, int wave) {
    XcdBarrier b; b.bar = bar; b.x = xb_xcc_id(); b.st = st; b.wave = wave;
    if (XB_TID0(b)) (void)xb_add(&bar[XB_XCNT(b.x)], 1u);
    return b;
}
__device__ __forceinline__ void xcd_barrier_complete(unsigned* bar, unsigned x, unsigned& nloc, unsigned& nx) {
    const unsigned G = gridDim.x * gridDim.y * gridDim.z;
    unsigned sum, cnt, mine, sp = 0u;
    for (;;) {
        sum = 0u; cnt = 0u; mine = 0u;
#pragma unroll
        for (unsigned j = 0; j < 16; ++j) { const unsigned c = xb_ld(&bar[XB_XCNT(j)]); sum += c; cnt += (c > 0u) ? 1u : 0u; mine = (j == x) ? c : mine; }
        if (sum == G) break;
        __builtin_amdgcn_s_sleep(1);
        if ((++sp & 255u) == 0u) { if (xb_ld(&bar[XB_TMO])) break; if (sp > XB_SPIN_CAP) { atomicAdd(&bar[XB_TMO], 1u); break; } }
    }
    nloc = mine > 0u ? mine : 1u; nx = cnt > 0u ? cnt : 1u;
}

__device__ __forceinline__ void xcd_barrier(const XcdBarrier& b) {
    asm volatile("s_waitcnt vmcnt(0)" ::: "memory");
    __syncthreads();
    if (XB_TID0(b)) {
        unsigned* bar = b.bar;
        __builtin_amdgcn_s_waitcnt(0);
        unsigned nloc = b.st[0], nx = b.st[1];
        if (nloc == 0u) { xcd_barrier_complete(bar, b.x, nloc, nx); b.st[0] = nloc; b.st[1] = nx; }
        const unsigned old = xb_add(&bar[XB_XSUB(b.x)], 1u);
        const unsigned gen = old / nloc;
        if (old + 1u == (gen + 1u) * nloc) {
            __builtin_amdgcn_fence(__ATOMIC_RELEASE, "agent");
            asm volatile("s_waitcnt vmcnt(0)" ::: "memory");
            const unsigned og = xb_add(&bar[XB_TOP], 1u);
            const unsigned tg = og / nx;
            if (og + 1u == (tg + 1u) * nx) xb_add(&bar[XB_TOPGEN], 1u);
            else XB_SPIN(xb_ld(&bar[XB_TOPGEN]) == tg, bar);
            __builtin_amdgcn_fence(__ATOMIC_ACQUIRE, "agent");
            xb_add(&bar[XB_XGEN(b.x)], 1u);
            asm volatile("s_waitcnt vmcnt(0)" ::: "memory");
        } else {
            XB_SPIN(xb_ld(&bar[XB_XGEN(b.x)]) == gen, bar);
            __builtin_amdgcn_fence(__ATOMIC_ACQUIRE, "agent");
            asm volatile("s_waitcnt vmcnt(0)" ::: "memory");
        }
    }
    __syncthreads();
}
constexpr int NWAVES = 8;
constexpr int D = 1024, TP = 4096, TS = 64, NBP = 4, NBS = 32, PAST = 2048;
constexpr int MP = NBP * TP, MS = NBS * TS, M = MP + MS;
constexpr int NH = 8, HDIM = 64, AW = 512, BW = 512, ECOLS = 2568, NE = 2560, FF = 2816, FF2 = 5632;
constexpr float ALPHA = 1.41421356237309505f, LN_EPS = 1e-5f, LOG2E = 1.4426950408889634f, QSCALE = 0.125f * 1.4426950408889634f;
static_assert(MP == pg8::E_MP, "prompt rows");
enum { I_XP = 0, I_XS, I_CK, I_CV, I_CLF, I_SRC, I_SRH, I_SFC, I_WINE, I_BF, I_RCW, I_RCB, I_RWA, I_RBA, I_RWX, I_RBX, I_RLAM, I_WOUTE, I_WINO, I_SGG, I_SGB, I_SGW, I_SGBIAS, I_WOUTO,
       I_LMG, I_LMB, I_LFG, I_LFB, I_WUP, I_FCW, I_FCB, I_WDN, N_IN };
constexpr size_t O_YP = 0, O_YS = O_YP + (size_t)MP * D, O_KP = O_YS + (size_t)MS * D, O_VP = O_KP + (size_t)MP * AW, O_LFP = O_VP + (size_t)MP * AW, O_KS = O_LFP + (size_t)MP * NH,
                 O_VS = O_KS + (size_t)MS * AW, O_LFS = O_VS + (size_t)MS * AW, O_RCP = O_LFS + (size_t)MS * NH, O_RHP = O_RCP + (size_t)NBP * 3 * BW, O_RCS = O_RHP + (size_t)NBP * BW,
                 O_RHS = O_RCS + (size_t)NBS * 3 * BW, O_FCP = O_RHS + (size_t)NBS * BW, O_FCS = O_FCP + (size_t)2 * NBP * 2 * FF2, O_SGV = O_FCS + (size_t)2 * NBS * 2 * FF2, O_END = O_SGV + (size_t)MS * D;
static_assert(O_END == 40878080, "output size");
constexpr size_t MiB = 1u << 20;
constexpr size_t WS_CTL = 0, CTL_ZERO_BYTES = 1 * MiB;
constexpr size_t WS_WINE = 2 * MiB, WS_WOUTE = 7 * MiB, WS_WINO = 9 * MiB, WS_WOUTO = 13 * MiB, WS_WUP0 = 15 * MiB, WS_WUP1 = 26 * MiB, WS_WDN0 = 37 * MiB, WS_WDN1 = WS_WDN0 + 5 * MiB + MiB / 2;
constexpr size_t WS_KBP = 48 * MiB, WS_KBS = WS_KBP + MiB / 2, WS_CARRY = 50 * MiB + 3 * (MiB / 4);
constexpr size_t WS_WAT = 52 * MiB - 2 * 65536, WS_WXT = 52 * MiB - 65536;
constexpr size_t WS_XA = 52 * MiB;
constexpr size_t WS_XR = 88 * MiB;
constexpr size_t WS_A = 160 * MiB;
constexpr size_t WS_Q = WS_A, WS_K = WS_A + 18 * MiB, WS_V = WS_A + 36 * MiB, WS_XB = WS_A + 54 * MiB, WS_GB = WS_A + 72 * MiB, WS_MIX = WS_A + 90 * MiB, WS_Y = WS_A + 126 * MiB;
constexpr size_t WS_H = WS_A;
constexpr size_t WS_U = WS_A, WS_VN = WS_A + 36 * MiB, WS_G = WS_A + 72 * MiB, WS_VR = WS_Y;
constexpr size_t WS_KC = WS_Y;
constexpr size_t WS_ACT = 358 * MiB, WS_VC = WS_ACT;
constexpr size_t WS_ACT_END = 457 * MiB;
constexpr size_t WS_PGB = 457 * MiB, WS_GBV = 459 * MiB, WS_END = 460 * MiB;
constexpr int NVEC = 2 * FF2 + 2 * D, VEC_UP0 = 0, VEC_UP1 = FF2, VEC_INO = 2 * FF2;
constexpr int CW_STAT = 32768;
static_assert(WS_WDN1 + (size_t)D * FF * 2 <= WS_KBP && WS_KBS + (size_t)256 * 2112 * 4 <= WS_CARRY && WS_CARRY + (size_t)2304 * 64 * 8 <= WS_WAT && WS_XA + (size_t)M * D * 2 == WS_XR && WS_XR + (size_t)M * D * 4 == WS_A, "ws map 1");
static_assert(WS_Y + (size_t)M * D * 4 == WS_ACT && WS_H + (size_t)M * FF2 * 2 == WS_ACT && WS_ACT + (size_t)M * FF * 2 == WS_ACT_END && WS_MIX + (size_t)M * D * 2 == WS_Y && WS_KC + (size_t)NBS * PAST * AW * 2 <= WS_ACT, "ws map 2");
static_assert((size_t)2 * 16 * NVEC * 4 <= 2 * MiB && (size_t)2 * NVEC * 4 <= MiB && ((size_t)CW_STAT + (size_t)4 * M * 2) * 4 <= CTL_ZERO_BYTES, "ws map 3");
constexpr int CW_TMO = 0, CW_CODE = 1, CW_BAR = 4096;
static_assert((CW_BAR + 3456) * 4 <= 32768, "the host memset (32 KiB) covers the barrier words");
constexpr int RING_OFF = 0, RING_BYTES = 131072, LDSCTL_OFF = RING_BYTES, MISC_OFF = LDSCTL_OFF + 320, LDS_BYTES = 147456;
struct Frame {
    LAS unsigned char* lds;
    volatile LAS unsigned* MISC;
    gu32* ctl;
    int wave;
    int vcu, G;
    float* out; unsigned char* ws;
};
typedef const float* cfptr_t;
__device__ __forceinline__ const float* inp_ptr(int i) { return ((const __attribute__((address_space(4))) cfptr_t*)__builtin_amdgcn_kernarg_segment_ptr())[i]; }
#define INP(i) inp_ptr(i)
__device__ __forceinline__ int flane() { int r; asm volatile("v_mbcnt_lo_u32_b32 %0, -1, 0\n\tv_mbcnt_hi_u32_b32 %0, -1, %0" : "=v"(r)); return r; }
__device__ __forceinline__ int ftid(const Frame& F) { return F.wave * 64 + flane(); }
__device__ __forceinline__ float bf2f(bf16 h) { return __builtin_bit_cast(float, (unsigned)h << 16); }
__device__ __forceinline__ float wave_sum(float v) {
#pragma unroll
    for (int o = 1; o < 64; o <<= 1) v += __shfl_xor(v, o);
    return v;
}
__device__ __forceinline__ void unpack8(v4u w, float (&v)[8]) {
    v[0] = __builtin_bit_cast(float, w.x << 16); v[1] = __builtin_bit_cast(float, w.x & 0xffff0000u); v[2] = __builtin_bit_cast(float, w.y << 16); v[3] = __builtin_bit_cast(float, w.y & 0xffff0000u);
    v[4] = __builtin_bit_cast(float, w.z << 16); v[5] = __builtin_bit_cast(float, w.z & 0xffff0000u); v[6] = __builtin_bit_cast(float, w.w << 16); v[7] = __builtin_bit_cast(float, w.w & 0xffff0000u);
}
__device__ __forceinline__ v4u pack8(const float (&v)[8]) { v4u o; o.x = pk2(v[0], v[1]); o.y = pk2(v[2], v[3]); o.z = pk2(v[4], v[5]); o.w = pk2(v[6], v[7]); return o; }
__device__ __forceinline__ float gelu_tanh_f(float x) { return pg8::gelu_tanh(x); }

__device__ __forceinline__ void tr_item(const float* W, int ldw, int K, bf16* WT, int src_col0, int dst_row0, int kb, LAS float* scr, int lane, const float* gsc = nullptr, const float* bsc = nullptr, float* PG = nullptr, float* PB = nullptr, int vec0 = 0) {
    const int k0 = 64 * kb;
#pragma unroll 8
    for (int i = 0; i < 32; ++i) { const int kk = 2 * i + (lane >> 5); scr[kk * 33 + (lane & 31)] = W[(size_t)(k0 + kk) * ldw + src_col0 + (lane & 31)]; }
    LDS_WAIT(); asm volatile("" ::: "memory");
    const int c = lane & 7;
    if (gsc) { float g8[8], b8[8];
#pragma unroll
        for (int i = 0; i < 8; ++i) { g8[i] = gsc[k0 + 8 * c + i]; b8[i] = bsc[k0 + 8 * c + i]; }
#pragma unroll
        for (int j = 0; j < 4; ++j) { const int n = (lane >> 3) + 8 * j; const LAS float* s = scr + (8 * c) * 33 + n; float w[8], pg = 0.f, pb = 0.f;
#pragma unroll
            for (int i = 0; i < 8; ++i) { w[i] = s[i * 33]; pb += b8[i] * w[i]; w[i] *= g8[i]; }
            v4u o; o.x = pk2(w[0], w[1]); o.y = pk2(w[2], w[3]); o.z = pk2(w[4], w[5]); o.w = pk2(w[6], w[7]);
            pg = (__builtin_bit_cast(float, o.x << 16) + __builtin_bit_cast(float, o.x & 0xffff0000u)) + (__builtin_bit_cast(float, o.y << 16) + __builtin_bit_cast(float, o.y & 0xffff0000u))
               + (__builtin_bit_cast(float, o.z << 16) + __builtin_bit_cast(float, o.z & 0xffff0000u)) + (__builtin_bit_cast(float, o.w << 16) + __builtin_bit_cast(float, o.w & 0xffff0000u));
            *(GAS v4u*)(WT + (size_t)(dst_row0 + n) * K + k0 + 8 * c) = o;
            pg += __shfl_xor(pg, 1); pg += __shfl_xor(pg, 2); pg += __shfl_xor(pg, 4); pb += __shfl_xor(pb, 1); pb += __shfl_xor(pb, 2); pb += __shfl_xor(pb, 4);
            if (c == 0) { PG[(size_t)kb * NVEC + vec0 + dst_row0 + n] = pg; PB[(size_t)kb * NVEC + vec0 + dst_row0 + n] = pb; } } }
    else {
#pragma unroll
    for (int j = 0; j < 4; ++j) { const int n = (lane >> 3) + 8 * j; const LAS float* s = scr + (8 * c) * 33 + n;
        v4u o; o.x = pk2(s[0 * 33], s[1 * 33]); o.y = pk2(s[2 * 33], s[3 * 33]); o.z = pk2(s[4 * 33], s[5 * 33]); o.w = pk2(s[6 * 33], s[7 * 33]);
        *(GAS v4u*)(WT + (size_t)(dst_row0 + n) * K + k0 + 8 * c) = o; } }
    LDS_WAIT(); asm volatile("" ::: "memory");
}
__device__ __forceinline__ float log_sigmoid_f(float z) { return z >= 0.f ? -log1pf(expf(-z)) : z - log1pf(expf(z)); }
__device__ __forceinline__ void weights_set(Frame& F, int set, int gw, int NGW) {
    LAS float* scr = (LAS float*)(F.lds + RING_OFF + F.wave * 16384); const int lane = flane();
    unsigned char* ws = F.ws; float* PG = (float*)(ws + WS_PGB); float* PB = PG + 16 * NVEC;
    constexpr int I0 = 16 * 80, I1 = 16 * 32, I2 = 16 * 64, I3 = 16 * 32, I4 = 16 * 176, I5 = I4, I6 = 44 * 32, I7 = I6;
    if (set == 0) for (int it = gw; it < I0 + I1 + I4 + I6; it += NGW) { int r = it;
        if (r < I0) { const int kb = r / 80, nb = r % 80; const int dst = 32 * nb, src = dst < 1536 ? dst : dst + 8; tr_item(INP(I_WINE), ECOLS, D, (bf16*)(ws + WS_WINE), src, dst, kb, scr, lane); continue; } r -= I0;
        if (r < I1) { tr_item(INP(I_WOUTE), D, D, (bf16*)(ws + WS_WOUTE), 32 * (r % 32), 32 * (r % 32), r / 32, scr, lane); continue; } r -= I1;
        if (r < I4) { const int sc = 32 * (r % 176); const int dr = sc < FF ? 256 * (sc / 128) + sc % 128 : 256 * ((sc - FF) / 128) + 128 + (sc - FF) % 128; tr_item(INP(I_WUP), FF2, D, (bf16*)(ws + WS_WUP0), sc, dr, r / 176, scr, lane, INP(I_LMG), INP(I_LMB), PG, PB, VEC_UP0); continue; } r -= I4;
        tr_item(INP(I_WDN), D, FF, (bf16*)(ws + WS_WDN0), 32 * (r % 32), 32 * (r % 32), r / 32, scr, lane); }
    else if (set == 1) for (int it = gw; it < I2 + I3; it += NGW) { int r = it;
        if (r < I2) { tr_item(INP(I_WINO), 2 * D, D, (bf16*)(ws + WS_WINO), 32 * (r % 64), 32 * (r % 64), r / 64, scr, lane, INP(I_LFG), INP(I_LFB), PG, PB, VEC_INO); continue; } r -= I2;
        tr_item(INP(I_WOUTO), D, D, (bf16*)(ws + WS_WOUTO), 32 * (r % 32), 32 * (r % 32), r / 32, scr, lane); }
    else for (int it = gw; it < I5 + I7; it += NGW) { int r = it;
        if (r < I5) { const int sc = 32 * (r % 176); const int dr = sc < FF ? 256 * (sc / 128) + sc % 128 : 256 * ((sc - FF) / 128) + 128 + (sc - FF) % 128; tr_item(INP(I_WUP) + (size_t)D * FF2, FF2, D, (bf16*)(ws + WS_WUP1), sc, dr, r / 176, scr, lane, INP(I_LMG) + D, INP(I_LMB) + D, PG, PB, VEC_UP1); continue; } r -= I5;
        tr_item(INP(I_WDN) + (size_t)FF * D, D, FF, (bf16*)(ws + WS_WDN1), 32 * (r % 32), 32 * (r % 32), r / 32, scr, lane); }
}
__device__ __forceinline__ void p0_prologue(Frame& F) {
    const int gw = F.vcu * NWAVES + F.wave, NGW = F.G * NWAVES, lane = flane();
    unsigned char* ws = F.ws;
    for (int i = F.vcu * 512 + ftid(F); i < (int)(CTL_ZERO_BYTES / 4) - 8192; i += F.G * 512) F.ctl[8192 + i] = 0u;
    weights_set(F, 0, gw, NGW);
    if (F.G != 256) { weights_set(F, 1, gw, NGW); weights_set(F, 2, gw, NGW); }
    const float* bfp = INP(I_BF);
    __syncthreads();
    { LAS float* wl = (LAS float*)(F.lds + RING_OFF); const float* wf = INP(I_WINE) + 1536;
      for (int k = ftid(F); k < D; k += 512) { const f32x4 a = *(const GAS f32x4*)(wf + (size_t)k * ECOLS), c = *(const GAS f32x4*)(wf + (size_t)k * ECOLS + 4);
          wl[k] = a.x; wl[D + k] = a.y; wl[2 * D + k] = a.z; wl[3 * D + k] = a.w; wl[4 * D + k] = c.x; wl[5 * D + k] = c.y; wl[6 * D + k] = c.z; wl[7 * D + k] = c.w; } }
    __syncthreads();
    f32x4 wfr[8][4];
#pragma unroll
    for (int hh = 0; hh < 8; ++hh)
#pragma unroll
        for (int j = 0; j < 4; ++j) wfr[hh][j] = *(const LAS f32x4*)((LAS float*)(F.lds + RING_OFF) + hh * D + 4 * lane + 256 * j);
    f32x4 vn[4];
    if (gw < M) { const GAS f32x4* xr = (const GAS f32x4*)(gw < MP ? INP(I_XP) + (size_t)gw * D : INP(I_XS) + (size_t)(gw - MP) * D) + lane;
#pragma unroll
        for (int j = 0; j < 4; ++j) vn[j] = xr[64 * j]; }
    for (int m = gw; m < M; m += NGW) {
        f32x4 v[4];
#pragma unroll
        for (int j = 0; j < 4; ++j) v[j] = vn[j];
        if (m + NGW < M) { const int mn = m + NGW; const GAS f32x4* xr = (const GAS f32x4*)(mn < MP ? INP(I_XP) + (size_t)mn * D : INP(I_XS) + (size_t)(mn - MP) * D) + lane;
#pragma unroll
            for (int j = 0; j < 4; ++j) vn[j] = xr[64 * j]; }
        GAS unsigned long long* o8 = (GAS unsigned long long*)((bf16*)(ws + WS_XA) + (size_t)m * D) + lane;
#pragma unroll
        for (int j = 0; j < 4; ++j) o8[64 * j] = (unsigned long long)pk2(v[j].x, v[j].y) | ((unsigned long long)pk2(v[j].z, v[j].w) << 32);
        float fh[8];
#pragma unroll
        for (int hh = 0; hh < 8; ++hh) { f32x4 t = v[0] * wfr[hh][0]; t += v[1] * wfr[hh][1]; t += v[2] * wfr[hh][2]; t += v[3] * wfr[hh][3]; fh[hh] = (t.x + t.y) + (t.z + t.w); }
        float f0 = fh[0], f1 = fh[1], f2 = fh[2], f3 = fh[3], f4 = fh[4], f5 = fh[5], f6 = fh[6], f7 = fh[7];
        f0 = wave_sum(f0); f1 = wave_sum(f1); f2 = wave_sum(f2); f3 = wave_sum(f3); f4 = wave_sum(f4); f5 = wave_sum(f5); f6 = wave_sum(f6); f7 = wave_sum(f7);
        if (lane < 8) { float fv = f0; fv = lane == 1 ? f1 : fv; fv = lane == 2 ? f2 : fv; fv = lane == 3 ? f3 : fv; fv = lane == 4 ? f4 : fv; fv = lane == 5 ? f5 : fv; fv = lane == 6 ? f6 : fv; fv = lane == 7 ? f7 : fv;
            const float lf = log_sigmoid_f(fv + bfp[lane]);
            if (m < MP) F.out[O_LFP + (size_t)m * NH + lane] = lf; else F.out[O_LFS + (size_t)(m - MP) * NH + lane] = lf; }
    }
    { bf16* WAT = (bf16*)(ws + WS_WAT); bf16* WXT = (bf16*)(ws + WS_WXT);
      for (int e = F.vcu * 512 + ftid(F); e < 8 * 64 * 64; e += F.G * 512) { const int nn = e >> 12, dd = (e >> 6) & 63, c = e & 63; WAT[e] = (bf16)f2bf(INP(I_RWA)[nn * 4096 + c * 64 + dd]); WXT[e] = (bf16)f2bf(INP(I_RWX)[nn * 4096 + c * 64 + dd]); } }
}

__device__ __forceinline__ void p2_scans(Frame& F, int gw, int NGW) {
    const int lane = flane();
    float* KBP = (float*)(F.ws + WS_KBP); float* KBS = (float*)(F.ws + WS_KBS);
    for (int it = gw; it < 32 + 256; it += NGW) {
        if (it < 32) { const int b = it >> 3, h = it & 7; const float* lf = F.out + O_LFP + (size_t)b * TP * NH + h;
            double s = 0.0;
#pragma unroll 16
            for (int i = 0; i < 64; ++i) s += (double)lf[(size_t)(64 * lane + i) * NH];
            double inc = s;
#pragma unroll
            for (int o = 1; o < 64; o <<= 1) { const double t = __shfl_up(inc, o); if (lane >= o) inc += t; }
            double run = inc - s;
#pragma unroll 16
            for (int i = 0; i < 64; ++i) { run += (double)lf[(size_t)(64 * lane + i) * NH]; KBP[(size_t)it * TP + 64 * lane + i] = (float)(-run * 1.4426950408889634); }
        } else { const int sid = it - 32, b = sid >> 3, h = sid & 7;
            { double inc = (double)F.out[O_LFS + (size_t)(b * TS + lane) * NH + h];
#pragma unroll
              for (int o = 1; o < 64; o <<= 1) { const double t = __shfl_up(inc, o); if (lane >= o) inc += t; }
              KBS[(size_t)sid * 2112 + PAST + lane] = (float)(-inc * 1.4426950408889634); }
            const float* lc = INP(I_CLF) + (size_t)b * PAST * NH + h;
            double s = 0.0;
#pragma unroll 16
            for (int i = 0; i < 32; ++i) s += (double)lc[(size_t)(32 * lane + i) * NH];
            double inc = s;
#pragma unroll
            for (int o = 1; o < 64; o <<= 1) { const double t = __shfl_down(inc, o); if (lane + o < 64) inc += t; }
            double run = inc - s;
            for (int i = 31; i >= 0; --i) { const int sx = 32 * lane + i; KBS[(size_t)sid * 2112 + sx] = (float)(run * 1.4426950408889634); run += (double)lc[(size_t)sx * NH]; }
        }
    }
}

__device__ __forceinline__ void p2_vecs(Frame& F, int v_lo, int v_hi, int gt0, int NTH) {
    const float* PG = (const float*)(F.ws + WS_PGB); const float* PB = PG + 16 * NVEC; float* GV = (float*)(F.ws + WS_GBV); float* BV = GV + NVEC;
    for (int i = v_lo + gt0; i < v_hi; i += NTH) { float g = 0.f, b = 0.f;
#pragma unroll
        for (int kb = 0; kb < 16; ++kb) { g += PG[(size_t)kb * NVEC + i]; b += PB[(size_t)kb * NVEC + i]; }
        GV[i] = g; BV[i] = b; }
}
constexpr int CW_NRM = 16384, NRM_QP = 0, NRM_KP = 512;
constexpr float PRUNE_T = 40.f;
__device__ __forceinline__ void p2_norms(Frame& F) {
    const bf16* Q = (const bf16*)(F.ws + WS_Q); const bf16* K = (const bf16*)(F.ws + WS_K); unsigned* NRM = (unsigned*)(F.ctl + CW_NRM);
    const int lane = flane(), hh = lane >> 3, part = lane & 7;
    for (int w = F.vcu * NWAVES + F.wave; w < MP / 8; w += F.G * NWAVES) { const int row0 = w * 8; float qm = 0.f, km = 0.f;
#pragma unroll 4
        for (int r = 0; r < 8; ++r) { float qv[8], kv[8]; unpack8(*(const GAS v4u*)(Q + (size_t)(row0 + r) * AW + hh * 64 + part * 8), qv); unpack8(*(const GAS v4u*)(K + (size_t)(row0 + r) * AW + hh * 64 + part * 8), kv);
            float q2 = 0.f, k2 = 0.f;
#pragma unroll
            for (int i = 0; i < 8; ++i) { q2 += qv[i] * qv[i]; k2 += kv[i] * kv[i]; }
            q2 += __shfl_xor(q2, 1); q2 += __shfl_xor(q2, 2); q2 += __shfl_xor(q2, 4); k2 += __shfl_xor(k2, 1); k2 += __shfl_xor(k2, 2); k2 += __shfl_xor(k2, 4);
            qm = fmaxf(qm, q2); km = fmaxf(km, k2); }
        if (part == 0) { const int b = row0 >> 12, qb = (row0 & (TP - 1)) >> 8; const float qn = sqrtf(qm) * 1.0001f, kn = sqrtf(km) * 1.0001f;
            atomicMax(NRM + NRM_QP + (b * 8 + hh) * 16 + qb, __float_as_uint(qn)); atomicMax(NRM + NRM_KP + b * 8 + hh, __float_as_uint(kn)); } }
}

constexpr int RG_PITCH = 72, RG_WAVE_LDS = 64 * RG_PITCH * 2;
__device__ __forceinline__ void rg_wave_item(Frame& F, int it, int pass, int ntq = -1) {
    LAS bf16* xt = (LAS bf16*)(F.lds + RING_OFF + F.wave * RG_WAVE_LDS);
    int b, n, chunk, row0; bool samp;
    if (it < 2048) { chunk = it & 63; n = (it >> 6) & 7; b = it >> 9; row0 = b * TP + chunk * 64; samp = false; }
    else { const int s = it - 2048; n = s & 7; b = s >> 3; chunk = 0; row0 = MP + b * TS; samp = true; }
    const int lane = flane(), fr = lane & 15, fq = lane >> 4;
    const bf16* XB = (const bf16*)(F.ws + WS_XB); const bf16* GB = (const bf16*)(F.ws + WS_GB); bf16* MIX = (bf16*)(F.ws + WS_MIX);
    float* CA = (float*)(F.ws + WS_CARRY); float* CH = CA + 2304 * 64;
    const bf16* WAT = (const bf16*)(F.ws + WS_WAT) + (size_t)n * 4096; const bf16* WXT = (const bf16*)(F.ws + WS_WXT) + (size_t)n * 4096;
    bf16x8 brA[4][2], biA[4][2]; float barA[4], bixA[4], lamA[4];
#pragma unroll
    for (int nt = 0; nt < 4; ++nt) { const int d = 16 * nt + fr;
#pragma unroll
        for (int ks = 0; ks < 2; ++ks) { brA[nt][ks] = *(const GAS bf16x8*)(WAT + d * 64 + 32 * ks + 8 * fq); biA[nt][ks] = *(const GAS bf16x8*)(WXT + d * 64 + 32 * ks + 8 * fq); }
        barA[nt] = INP(I_RBA)[n * 64 + d]; bixA[nt] = INP(I_RBX)[n * 64 + d]; lamA[nt] = INP(I_RLAM)[n * 64 + d]; }
    float hin[4];
    if (pass == 2) {
#pragma unroll
        for (int nt = 0; nt < 4; ++nt) { if (ntq >= 0 && nt != ntq) { hin[nt] = 0.f; continue; } const int d = 16 * nt + fr; float h = samp ? INP(I_SRH)[(size_t)b * BW + n * 64 + d] : 0.f;
            if (chunk > 0) { const int S4 = (chunk + 3) >> 2, c_lo = fq * S4, c_hi = min(c_lo + S4, chunk); float Aq = 1.f, Hq = 0.f;
#pragma unroll 4
                for (int cc = c_lo; cc < c_hi; ++cc) { const size_t pit = (size_t)(it - chunk + cc) * 64 + d; const float ca = CA[pit], chv = CH[pit]; Hq = ca * Hq + chv; Aq *= ca; }
#pragma unroll
                for (int g = 0; g < 4; ++g) { const float ag = __shfl(Aq, fr + 16 * g), hg = __shfl(Hq, fr + 16 * g); h = ag * h + hg; } }
            hin[nt] = h; } }
    { const int cq = lane & 7, tg = lane >> 3, ch0 = n * 64 + cq * 8;
      float w0[8], w1[8], w2[8], w3[8], cb[8];
#pragma unroll
      for (int q = 0; q < 2; ++q) { const f32x4 a = *(const GAS f32x4*)(INP(I_RCW) + ch0 + 4 * q), b1 = *(const GAS f32x4*)(INP(I_RCW) + BW + ch0 + 4 * q), c1 = *(const GAS f32x4*)(INP(I_RCW) + 2 * BW + ch0 + 4 * q),
            d1 = *(const GAS f32x4*)(INP(I_RCW) + 3 * BW + ch0 + 4 * q), e1 = *(const GAS f32x4*)(INP(I_RCB) + ch0 + 4 * q);
#pragma unroll
          for (int i = 0; i < 4; ++i) { w0[4 * q + i] = a[i]; w1[4 * q + i] = b1[i]; w2[4 * q + i] = c1[i]; w3[4 * q + i] = d1[i]; cb[4 * q + i] = e1[i]; } }
      float x0[8], x1[8], x2[8];
      const int tfirst = 8 * tg;
#pragma unroll
      for (int j = 0; j < 3; ++j) { const int t = tfirst - 3 + j; float v[8];
          if (chunk == 0 && t < 0) {
              if (samp) { const float* sp = INP(I_SRC) + ((size_t)b * 3 + (t + 3)) * BW + ch0;
#pragma unroll
                  for (int i = 0; i < 8; ++i) v[i] = sp[i]; }
              else {
#pragma unroll
                  for (int i = 0; i < 8; ++i) v[i] = 0.f; } }
          else unpack8(*(const GAS v4u*)(XB + (size_t)(row0 + t) * BW + ch0), v);
#pragma unroll
          for (int i = 0; i < 8; ++i) { if (j == 0) x0[i] = v[i]; else if (j == 1) x1[i] = v[i]; else x2[i] = v[i]; } }
#pragma unroll
      for (int j = 0; j < 8; ++j) { const int t = tfirst + j; float x3[8], y[8]; unpack8(*(const GAS v4u*)(XB + (size_t)(row0 + t) * BW + ch0), x3);
#pragma unroll
          for (int i = 0; i < 8; ++i) { y[i] = cb[i] + w0[i] * x0[i] + w1[i] * x1[i] + w2[i] * x2[i] + w3[i] * x3[i]; x0[i] = x1[i]; x1[i] = x2[i]; x2[i] = x3[i]; }
          *(LAS v4u*)(xt + t * RG_PITCH + cq * 8) = pack8(y); } }
    bf16x8 af[4][2];
#pragma unroll
    for (int m = 0; m < 4; ++m)
#pragma unroll
        for (int ks = 0; ks < 2; ++ks) af[m][ks] = *(const LAS bf16x8*)(xt + ((fr >> 2) * 16 + 4 * m + (fr & 3)) * RG_PITCH + 32 * ks + 8 * fq);
#pragma unroll
    for (int nt = 0; nt < 4; ++nt) { if (ntq >= 0 && nt != ntq) continue; const int d = 16 * nt + fr, ch = n * 64 + d;
        const bf16x8 (&br)[2] = brA[nt]; const bf16x8 (&bi)[2] = biA[nt];
        const float bar = barA[nt], bix = bixA[nt]; const float sp8 = 8.f * LOG2E * log1pf(expf(-lamA[nt]));
        float a[16], u[16];
#pragma unroll
        for (int m = 0; m < 4; ++m) { f32x4 ar = {0.f, 0.f, 0.f, 0.f}, ai = {0.f, 0.f, 0.f, 0.f};
#pragma unroll
            for (int ks = 0; ks < 2; ++ks) { ar = __builtin_amdgcn_mfma_f32_16x16x32_bf16(af[m][ks], br[ks], ar, 0, 0, 0); ai = __builtin_amdgcn_mfma_f32_16x16x32_bf16(af[m][ks], bi[ks], ai, 0, 0, 0); }
#pragma unroll
            for (int r = 0; r < 4; ++r) { const int t = fq * 16 + 4 * m + r;
                const float gr = __builtin_amdgcn_rcpf(1.f + __builtin_amdgcn_exp2f(-LOG2E * (ar[r] + bar))), gi = __builtin_amdgcn_rcpf(1.f + __builtin_amdgcn_exp2f(-LOG2E * (ai[r] + bix)));
                const float av = __builtin_amdgcn_exp2f(-sp8 * gr); const float xcv = bf2f(xt[t * RG_PITCH + d]);
                a[4 * m + r] = av; u[4 * m + r] = __builtin_amdgcn_sqrtf(fmaxf(1.f - av * av, 0.f)) * gi * xcv; } }
        float A = 1.f, Hh = 0.f;
#pragma unroll
        for (int k = 0; k < 16; ++k) { Hh = a[k] * Hh + u[k]; A *= a[k]; }
        float Ag[4], Hg[4];
#pragma unroll
        for (int g = 0; g < 4; ++g) { Ag[g] = __shfl(A, fr + 16 * g); Hg[g] = __shfl(Hh, fr + 16 * g); }
        if (pass == 1) { float At = 1.f, Ht = 0.f;
#pragma unroll
            for (int g = 0; g < 4; ++g) { Ht = Ag[g] * Ht + Hg[g]; At *= Ag[g]; }
            if (fq == 0) { CA[(size_t)it * 64 + d] = At; CH[(size_t)it * 64 + d] = Ht; } }
        else { float h = hin[nt];
#pragma unroll
            for (int g = 0; g < 3; ++g) if (g < fq) h = Ag[g] * h + Hg[g];
#pragma unroll
            for (int k = 0; k < 16; ++k) { h = a[k] * h + u[k]; xt[(fq * 16 + k) * RG_PITCH + d] = (bf16)f2bf(h); }
            if (fq == 3 && (samp || chunk == 63)) F.out[(samp ? O_RHS : O_RHP) + (size_t)b * BW + ch] = h; }
    }
    if (pass == 2) { const int cq = lane & 7, tg = lane >> 3;
        if (ntq < 0 || (cq >> 1) == ntq) { v4u gw8[8];
#pragma unroll
            for (int j = 0; j < 8; ++j) gw8[j] = *(const GAS v4u*)(GB + (size_t)(row0 + 8 * tg + j) * BW + n * 64 + cq * 8);
#pragma unroll
            for (int j = 0; j < 8; ++j) { const int t = 8 * tg + j; float hv[8], gv[8]; unpack8(*(const LAS v4u*)(xt + t * RG_PITCH + cq * 8), hv); unpack8(gw8[j], gv);
#pragma unroll
                for (int i = 0; i < 8; ++i) hv[i] *= gv[i];
                *(GAS v4u*)(MIX + (size_t)(row0 + t) * D + AW + n * 64 + cq * 8) = pack8(hv); } } }
}

namespace att {
typedef short bf16x8 __attribute__((ext_vector_type(8)));
typedef short s16x4 __attribute__((ext_vector_type(4)));
typedef float f32x16 __attribute__((ext_vector_type(16)));
typedef unsigned u32x4 __attribute__((ext_vector_type(4)));
typedef float f32x2_t __attribute__((ext_vector_type(2))); typedef __bf16 bf16x2_t __attribute__((ext_vector_type(2)));
__device__ __forceinline__ int crow(int r, int hi) { return (r & 3) + 8 * (r >> 2) + 4 * hi; }
__device__ __forceinline__ unsigned cvtpk_s(float lo, float hi) { f32x2_t v = {lo, hi}; bf16x2_t b = __builtin_convertvector(v, bf16x2_t); return __builtin_bit_cast(unsigned, b); }
__device__ __forceinline__ s16x4 vtr(const LAS char* p) { return __builtin_bit_cast(s16x4, __builtin_amdgcn_ds_read_tr16_b64_v4i16((LAS s16x4*)p)); }
__device__ __forceinline__ void qkt(f32x16& p0, f32x16& p1, const LAS char* Kslot, const bf16x8 (&qr)[4], int r32, int hi) {
    const LAS char* kb = Kslot + hi * 1024 + r32 * 16;
    f32x16 z0 = {}, z1 = {};
#pragma unroll
    for (int d0 = 0; d0 < 4; ++d0) { const bf16x8 b0 = *(const LAS bf16x8*)(kb + d0 * 2048); const bf16x8 b1 = *(const LAS bf16x8*)(kb + d0 * 2048 + 512);
        z0 = __builtin_amdgcn_mfma_f32_32x32x16_bf16(b0, qr[d0], z0, 0, 0, 0); z1 = __builtin_amdgcn_mfma_f32_32x32x16_bf16(b1, qr[d0], z1, 0, 0, 0); }
    p0 = z0; p1 = z1;
}
__device__ __forceinline__ void pv(f32x16 (&o)[2], const LAS char* vp, bf16x8 pa0, bf16x8 pa1, bf16x8 pa2, bf16x8 pa3) {
#pragma unroll
    for (int d0 = 0; d0 < 2; ++d0) { bf16x8 vf[4];
#pragma unroll
        for (int ks = 0; ks < 4; ++ks) { const s16x4 lo = vtr(vp + d0 * 4096 + ks * 1024), hi = vtr(vp + d0 * 4096 + ks * 1024 + 512); vf[ks] = (bf16x8){lo[0], lo[1], lo[2], lo[3], hi[0], hi[1], hi[2], hi[3]}; }
        o[d0] = __builtin_amdgcn_mfma_f32_32x32x16_bf16(pa0, vf[0], o[d0], 0, 0, 0); o[d0] = __builtin_amdgcn_mfma_f32_32x32x16_bf16(pa1, vf[1], o[d0], 0, 0, 0);
        o[d0] = __builtin_amdgcn_mfma_f32_32x32x16_bf16(pa2, vf[2], o[d0], 0, 0, 0); o[d0] = __builtin_amdgcn_mfma_f32_32x32x16_bf16(pa3, vf[3], o[d0], 0, 0, 0); }
}
__device__ __forceinline__ void load_kb(f32x4 (&kb)[8], const float* kbt0, int hi) {
#pragma unroll
    for (int g = 0; g < 4; ++g) { kb[g] = *(const GAS f32x4*)(kbt0 + 4 * hi + 8 * g); kb[4 + g] = *(const GAS f32x4*)(kbt0 + 4 * hi + 32 + 8 * g); }
}
__device__ __forceinline__ void tile_step(float& m_run, float& l_run, f32x16 (&o)[2], const LAS char* Kslot, const LAS char* vp, const bf16x8 (&qr)[4], const f32x4 (&kb)[8], int kpos0, int qpos, bool need_mask, LAS float* wsf, int r32, int hi) {
    f32x16 p0, p1; qkt(p0, p1, Kslot, qr, r32, hi);
#pragma unroll
    for (int g = 0; g < 4; ++g) { const f32x4 b0 = kb[g], b1 = kb[4 + g];
#pragma unroll
        for (int e = 0; e < 4; ++e) { p0[4 * g + e] += b0[e]; p1[4 * g + e] += b1[e]; } }
    if (need_mask) {
#pragma unroll
        for (int r = 0; r < 16; ++r) { const int kv = kpos0 + crow(r, hi); if (kv > qpos) p0[r] = -INFINITY; if (kv + 32 > qpos) p1[r] = -INFINITY; } }
    float rm = fmaxf(p0[0], p1[0]);
#pragma unroll
    for (int r = 1; r < 16; ++r) rm = fmaxf(rm, fmaxf(p0[r], p1[r]));
    rm = fmaxf(rm, __shfl_xor(rm, 32));
    const float mn = fmaxf(m_run, rm); const float f = __builtin_amdgcn_exp2f(m_run - mn); m_run = mn;
    float rs = 0.f;
#pragma unroll
    for (int r = 0; r < 16; ++r) { p0[r] = __builtin_amdgcn_exp2f(p0[r] - mn); p1[r] = __builtin_amdgcn_exp2f(p1[r] - mn); rs += p0[r] + p1[r]; }
    l_run = l_run * f + rs;
    if (hi == 0) wsf[r32] = f;
#pragma unroll
    for (int r = 0; r < 16; ++r) { const float fr_ = wsf[crow(r, hi)]; o[0][r] *= fr_; o[1][r] *= fr_; }
    u32x4 pw0, pw1, pw2, pw3;
    pw0 = (u32x4){cvtpk_s(p0[0], p0[1]), cvtpk_s(p0[2], p0[3]), cvtpk_s(p0[4], p0[5]), cvtpk_s(p0[6], p0[7])}; pw1 = (u32x4){cvtpk_s(p0[8], p0[9]), cvtpk_s(p0[10], p0[11]), cvtpk_s(p0[12], p0[13]), cvtpk_s(p0[14], p0[15])};
    pw2 = (u32x4){cvtpk_s(p1[0], p1[1]), cvtpk_s(p1[2], p1[3]), cvtpk_s(p1[4], p1[5]), cvtpk_s(p1[6], p1[7])}; pw3 = (u32x4){cvtpk_s(p1[8], p1[9]), cvtpk_s(p1[10], p1[11]), cvtpk_s(p1[12], p1[13]), cvtpk_s(p1[14], p1[15])};
    pv(o, vp, __builtin_bit_cast(bf16x8, pw0), __builtin_bit_cast(bf16x8, pw1), __builtin_bit_cast(bf16x8, pw2), __builtin_bit_cast(bf16x8, pw3));
}
struct KV { const bf16* k0; const bf16* v0; const bf16* k1; const bf16* v1; int nt0; };
__device__ __forceinline__ void unit(LAS unsigned char* lds, int tid, const bf16* Qrows, int nqw, const KV S, int t_begin, int NT, const float* kbias, int qpos0, bf16* Odst) {
    const int lane = tid & 63, wid = __builtin_amdgcn_readfirstlane(tid >> 6), r32 = lane & 31, hi = lane >> 5;
    const bool active = wid < nqw;
    LAS char* Kb = (LAS char*)lds; LAS char* Vb = Kb + 16384; LAS float* wsf = (LAS float*)(Kb + 32768) + wid * 64; LAS bf16* stg = (LAS bf16*)(Kb + 32768 + 2048) + wid * 2048;
    bf16x8 qr[4];
#pragma unroll
    for (int d0 = 0; d0 < 4; ++d0) qr[d0] = active ? *(const GAS bf16x8*)(Qrows + (size_t)(wid * 32 + r32) * 512 + d0 * 16 + hi * 8) : (bf16x8){0, 0, 0, 0, 0, 0, 0, 0};
    float m_run = -INFINITY, l_run = 0.f; f32x16 o[2]; o[0] = f32x16{}; o[1] = f32x16{};
    const int qlo = qpos0 + wid * 32, qhi = qlo + 31, qpos = qlo + r32;
    const size_t koff = (size_t)lane * 512 + wid * 8, voff = (size_t)(16 * (wid & 3) + (lane >> 2)) * 512 + (wid >> 2) * 32 + (lane & 3) * 8;
    const int ldst = wid * 1024 + lane * 16;
    const LAS char* vp0 = Vb + ((lane >> 4) & 1) * 32 + (lane & 3) * 8 + (4 * hi + ((lane & 15) >> 2)) * 64;
    u32x4 kreg, vreg;
    { const int tn = t_begin; const bf16* kt = tn < S.nt0 ? S.k0 + (size_t)tn * 64 * 512 : S.k1 + (size_t)(tn - S.nt0) * 64 * 512; const bf16* vt = tn < S.nt0 ? S.v0 + (size_t)tn * 64 * 512 : S.v1 + (size_t)(tn - S.nt0) * 64 * 512;
      kreg = *(const GAS u32x4*)(kt + koff); vreg = *(const GAS u32x4*)(vt + voff); }
    { const int s0 = (t_begin & 1) * 8192; *(LAS u32x4*)(Kb + s0 + ldst) = kreg; *(LAS u32x4*)(Vb + s0 + ldst) = vreg; }
    f32x4 kbc[8], kbn[8]; load_kb(kbc, kbias + 64 * t_begin, hi);
    __syncthreads();
    for (int t = t_begin; t < NT; ++t) {
        const int slot = (t & 1) * 8192;
        if (t + 1 < NT) load_kb(kbn, kbias + 64 * (t + 1), hi);
        if (t + 1 < NT) { const int tn = t + 1; const bf16* kt = tn < S.nt0 ? S.k0 + (size_t)tn * 64 * 512 : S.k1 + (size_t)(tn - S.nt0) * 64 * 512; const bf16* vt = tn < S.nt0 ? S.v0 + (size_t)tn * 64 * 512 : S.v1 + (size_t)(tn - S.nt0) * 64 * 512;
            kreg = *(const GAS u32x4*)(kt + koff); vreg = *(const GAS u32x4*)(vt + voff); }
        if (active && 64 * t <= qhi) tile_step(m_run, l_run, o, Kb + slot, vp0 + slot, qr, kbc, 64 * t, qpos, 64 * t + 63 > qlo, wsf, r32, hi);
#pragma unroll
        for (int g = 0; g < 8; ++g) kbc[g] = kbn[g];
        if (t + 1 < NT) { const int ns = ((t + 1) & 1) * 8192; *(LAS u32x4*)(Kb + ns + ldst) = kreg; *(LAS u32x4*)(Vb + ns + ldst) = vreg; }
        __syncthreads();
    }
    if (active) {
        const float lt = l_run + __shfl_xor(l_run, 32);
        if (hi == 0) wsf[32 + r32] = lt;
#pragma unroll
        for (int r = 0; r < 16; ++r) { const int orow = crow(r, hi); const float rl = 1.0f / wsf[32 + orow];
            stg[orow * 64 + r32] = (bf16)f2bf(o[0][r] * rl); stg[orow * 64 + 32 + r32] = (bf16)f2bf(o[1][r] * rl); }
#pragma unroll
        for (int i = 0; i < 4; ++i) { const int row = i * 8 + (lane >> 3), ch = lane & 7; const u32x4 v = *(const LAS u32x4*)(stg + row * 64 + ch * 8); *(GAS u32x4*)(Odst + (size_t)(wid * 32 + row) * D + ch * 8) = v; }
    }
    __syncthreads();
}
__device__ __forceinline__ void unit_sample(LAS unsigned char* lds, int tid, int b, int h, const bf16* Q, const bf16* Kn, const bf16* Vn, const float* Kc, const float* Vc, const float* kbias, bf16* MIXp) {
    const int lane = tid & 63, wid = __builtin_amdgcn_readfirstlane(tid >> 6), r32 = lane & 31, hi = lane >> 5, qh = wid & 1, sp = wid >> 1;
    LAS char* Kb = (LAS char*)lds + sp * 16384; LAS char* Vb = Kb + 8192; LAS float* wsf = (LAS float*)((LAS char*)lds + 131584) + wid * 64;
    const size_t qrow0 = (size_t)MP + (size_t)b * TS;
    bf16x8 qr[4];
#pragma unroll
    for (int d0 = 0; d0 < 4; ++d0) qr[d0] = *(const GAS bf16x8*)(Q + (qrow0 + qh * 32 + r32) * AW + h * 64 + d0 * 16 + hi * 8);
    float m_run = -INFINITY, l_run = 0.f; f32x16 o[2]; o[0] = f32x16{}; o[1] = f32x16{};
    const int qpos = PAST + qh * 32 + r32, qlo = PAST + qh * 32;
    const LAS char* vp0 = Vb + ((lane >> 4) & 1) * 32 + (lane & 3) * 8 + (4 * hi + ((lane & 15) >> 2)) * 64;
    const int ls = qh * 64 + lane;
    f32x4 kf[4][2], vf[4][2];
#define SLOAD(t) do { const size_t rb_ = ((size_t)b * PAST + 64 * (size_t)(t)) * AW + h * 64; _Pragma("unroll") for (int i_ = 0; i_ < 4; ++i_) { const int e_ = ls + 128 * i_; \
        const GAS f32x4* kp_ = (const GAS f32x4*)(Kc + rb_ + (size_t)(e_ >> 3) * AW + (e_ & 7) * 8); kf[i_][0] = kp_[0]; kf[i_][1] = kp_[1]; \
        const GAS f32x4* vq_ = (const GAS f32x4*)(Vc + rb_ + (size_t)(e_ >> 3) * AW + (e_ & 7) * 8); vf[i_][0] = vq_[0]; vf[i_][1] = vq_[1]; } } while (0)
#define VIDX(e_) (((((e_) & 7) >> 2) * 4 + ((e_) >> 7)) * 64 + (((e_) >> 3) & 15) * 4 + ((e_) & 3))
#define SSTORE(bo_) do { _Pragma("unroll") for (int i_ = 0; i_ < 4; ++i_) { const int e_ = ls + 128 * i_; u32x4 w_; \
        w_.x = cvtpk_s(kf[i_][0][0], kf[i_][0][1]); w_.y = cvtpk_s(kf[i_][0][2], kf[i_][0][3]); w_.z = cvtpk_s(kf[i_][1][0], kf[i_][1][1]); w_.w = cvtpk_s(kf[i_][1][2], kf[i_][1][3]); *(LAS u32x4*)(Kb + (bo_) + (e_ & 7) * 1024 + (e_ >> 3) * 16) = w_; \
        w_.x = cvtpk_s(vf[i_][0][0], vf[i_][0][1]); w_.y = cvtpk_s(vf[i_][0][2], vf[i_][0][3]); w_.z = cvtpk_s(vf[i_][1][0], vf[i_][1][1]); w_.w = cvtpk_s(vf[i_][1][2], vf[i_][1][3]); *(LAS u32x4*)(Vb + (bo_) + VIDX(e_) * 16) = w_; } } while (0)
    SLOAD(sp);
    SSTORE(0);
    f32x4 kbc[8];
    __syncthreads();
    for (int s = 0; s < 8; ++s) {
        const int t = 4 * s + sp; const int cur = (s & 1) * 65536, nxt = 65536 - cur;
        load_kb(kbc, kbias + 64 * t, hi);
        if (s < 7) SLOAD(t + 4);
        tile_step(m_run, l_run, o, Kb + cur, vp0 + cur, qr, kbc, 64 * t, qpos, false, wsf, r32, hi);
        if (s < 7) SSTORE(nxt);
        else if (sp == 0) {
#pragma unroll
            for (int i_ = 0; i_ < 4; ++i_) { const int e_ = ls + 128 * i_;
                *(LAS u32x4*)(Kb + nxt + (e_ & 7) * 1024 + (e_ >> 3) * 16) = *(const GAS u32x4*)(Kn + (qrow0 + (e_ >> 3)) * AW + h * 64 + (e_ & 7) * 8);
                *(LAS u32x4*)(Vb + nxt + VIDX(e_) * 16) = *(const GAS u32x4*)(Vn + (qrow0 + (e_ >> 3)) * AW + h * 64 + (e_ & 7) * 8); } }
        __syncthreads();
    }
    if (sp == 0) { load_kb(kbc, kbias + 64 * 32, hi); tile_step(m_run, l_run, o, Kb, vp0, qr, kbc, 64 * 32, qpos, true, wsf, r32, hi); }
#undef SLOAD
#undef SSTORE
#undef VIDX
    __syncthreads();
    LAS float* cb = (LAS float*)lds + wid * (32 * 65); LAS float* ml = (LAS float*)((LAS char*)lds + 8 * 32 * 65 * 4) + wid * 64;
    { const float lt = l_run + __shfl_xor(l_run, 32); if (hi == 0) { ml[r32] = m_run; ml[32 + r32] = lt; }
#pragma unroll
      for (int r = 0; r < 16; ++r) { const int q = crow(r, hi); cb[q * 65 + r32] = o[0][r]; cb[q * 65 + 32 + r32] = o[1][r]; } }
    __syncthreads();
    if (sp == 0) { const int q = lane & 31, dh = lane >> 5;
        float mt = -INFINITY, w[4], lt = 0.f;
#pragma unroll
        for (int s2 = 0; s2 < 4; ++s2) mt = fmaxf(mt, ((LAS float*)((LAS char*)lds + 8 * 32 * 65 * 4) + (2 * s2 + qh) * 64)[q]);
#pragma unroll
        for (int s2 = 0; s2 < 4; ++s2) { const LAS float* mls = (LAS float*)((LAS char*)lds + 8 * 32 * 65 * 4) + (2 * s2 + qh) * 64; w[s2] = __builtin_amdgcn_exp2f(mls[q] - mt); lt += w[s2] * mls[32 + q]; }
        const float rl = 1.0f / lt;
#pragma unroll
        for (int c8 = 0; c8 < 4; ++c8) { float ov[8];
#pragma unroll
            for (int i = 0; i < 8; ++i) { const int d = dh * 32 + c8 * 8 + i; float acc = 0.f;
#pragma unroll
                for (int s2 = 0; s2 < 4; ++s2) acc += w[s2] * ((LAS float*)lds + (2 * s2 + qh) * (32 * 65))[q * 65 + d];
                ov[i] = acc * rl; }
            *(GAS v4u*)(MIXp + (qrow0 + qh * 32 + q) * D + h * 64 + dh * 32 + c8 * 8) = pack8(ov); } }
    __syncthreads();
}
}

__device__ __forceinline__ void p3_mixer(Frame& F) {
    const bf16* Q = (const bf16*)(F.ws + WS_Q); const bf16* K = (const bf16*)(F.ws + WS_K); const bf16* V = (const bf16*)(F.ws + WS_V); bf16* MIX = (bf16*)(F.ws + WS_MIX);
    const float* KBP = (const float*)(F.ws + WS_KBP); const float* KBS = (const float*)(F.ws + WS_KBS); const unsigned* NRM = (const unsigned*)(F.ctl + CW_NRM);
    const bool sample_first = (blockIdx.x & 8) != 0;
    if (sample_first) for (int i = F.vcu; i < 256; i += F.G) att::unit_sample(F.lds + RING_OFF, ftid(F), i >> 3, i & 7, Q, K, V, INP(I_CK), INP(I_CV), KBS + (size_t)i * 2112, MIX);
    for (int i = F.vcu; i < 512; i += F.G) { const int j = i & 255, bh = j >> 3, s = j & 7, qb = i < 256 ? 15 - s : s, b = bh >> 3, h = bh & 7;
        const size_t r0 = (size_t)b * TP; att::KV S{K + r0 * AW + h * 64, V + r0 * AW + h * 64, K + r0 * AW + h * 64, V + r0 * AW + h * 64, 4 * qb + 4};
        const float qk2 = 2.f * __uint_as_float(__hip_atomic_load(NRM + NRM_QP + bh * 16 + qb, RLX_AGENT)) * __uint_as_float(__hip_atomic_load(NRM + NRM_KP + bh, RLX_AGENT)); const float* kbp = KBP + (size_t)bh * TP; const float thr = kbp[256 * qb] - PRUNE_T - qk2;
        int lo_; { const int ln = flane(); const float kv_ = ln < 4 * qb ? kbp[64 * ln + 63] : 3.0e38f; const unsigned long long keep = __ballot(kv_ >= thr); lo_ = keep ? (int)__builtin_ctzll(keep) : 4 * qb; lo_ = lo_ < 4 * qb ? lo_ : 4 * qb; }
        att::unit(F.lds + RING_OFF, ftid(F), Q + (r0 + 256 * qb) * AW + h * 64, 8, S, lo_, 4 * qb + 4, kbp, 256 * qb, MIX + (r0 + 256 * qb) * D + h * 64); }
    if (!sample_first) for (int i = F.vcu; i < 256; i += F.G) att::unit_sample(F.lds + RING_OFF, ftid(F), i >> 3, i & 7, Q, K, V, INP(I_CK), INP(I_CV), KBS + (size_t)i * 2112, MIX);
    { const int gw_ = F.vcu * NWAVES + F.wave, NGW_ = F.G * NWAVES;
      for (int it = gw_; it < 2048; it += NGW_) rg_wave_item(F, it, 2);
      if (NGW_ == 2048) { if (gw_ & 1) { const int q = gw_ >> 1; rg_wave_item(F, 2048 + (q >> 2), 2, q & 3); } }
      else for (int it = 2048 + gw_; it < 2304; it += NGW_) rg_wave_item(F, it, 2); }
    __syncthreads();
}

constexpr int LDSX_OFF = 131584;
static_assert(LDSX_OFF >= MISC_OFF + 128 && LDSX_OFF + 8192 <= LDS_BYTES, "LDS map: spare region");
__device__ __forceinline__ void stage_gb(Frame& F, const float* g, const float* b) {
    LAS float* d = (LAS float*)(F.lds + LDSX_OFF);
    for (int i = ftid(F); i < 1024; i += 512) { d[i] = g[i]; d[1024 + i] = b[i]; }
    __syncthreads();
}
typedef float mini_f32x16 __attribute__((ext_vector_type(16)));
__device__ __forceinline__ mini_f32x16 mini_acc(Frame& F, const bf16* A, const bf16* Bt, int K, int mb, int nb) {
    typedef float f32x16 __attribute__((ext_vector_type(16)));
    const int lane = flane(), wid = F.wave, tid = ftid(F), r32 = lane & 31, hi = lane >> 5, wm = wid & 1, wn = wid >> 1;
    LAS unsigned char* sb = F.lds + RING_OFF;
    const unsigned char* gsrc[6]; int ldst[6];
#pragma unroll
    for (int i = 0; i < 6; ++i) { const int item = tid + 512 * i; const int rr = item < 1024 ? (item >> 4) : ((item - 1024) >> 4), c = item & 15;
        gsrc[i] = item < 1024 ? (const unsigned char*)(A + (size_t)(MP + 64 * mb + rr) * K) + 16 * c : (const unsigned char*)(Bt + (size_t)(128 * nb + rr) * K) + 16 * c;
        ldst[i] = (item < 1024 ? 0 : 16384) + rr * 256 + ((c ^ (rr & 7)) << 4); }
    const int arow = 32 * wm + r32, brow = 32 * wn + r32;
    v4u sA[6], sB[6];
#pragma unroll
    for (int i = 0; i < 6; ++i) sA[i] = *(const GAS v4u*)(gsrc[i]);
    const int nq = K / 128;
#pragma unroll
    for (int i = 0; i < 6; ++i) sB[i] = *(const GAS v4u*)(gsrc[i] + 256);
#pragma unroll
    for (int i = 0; i < 6; ++i) *(LAS v4u*)(sb + ldst[i]) = sA[i];
    __syncthreads();
    f32x16 acc = {};
#define MINI_STEP(q_, S_, L_) do { const int cur = ((q_) & 1) * 49152; \
        if ((q_) + 2 < nq) { _Pragma("unroll") for (int i = 0; i < 6; ++i) L_[i] = *(const GAS v4u*)(gsrc[i] + 256 * ((q_) + 2)); } \
        _Pragma("unroll") for (int i = 0; i < 8; ++i) { const int c = 2 * i + hi; \
            const bf16x8 xa = *(const LAS bf16x8*)(sb + cur + arow * 256 + ((c ^ (arow & 7)) << 4)), wb = *(const LAS bf16x8*)(sb + cur + 16384 + brow * 256 + ((c ^ (brow & 7)) << 4)); \
            acc = __builtin_amdgcn_mfma_f32_32x32x16_bf16(wb, xa, acc, 0, 0, 0); } \
        if ((q_) + 1 < nq) { _Pragma("unroll") for (int i = 0; i < 6; ++i) *(LAS v4u*)(sb + (49152 - cur) + ldst[i]) = S_[i]; } \
        __syncthreads(); } while (0)
    for (int q = 0; q < nq; q += 2) { MINI_STEP(q, sB, sA); MINI_STEP(q + 1, sA, sB); }
#undef MINI_STEP
    return acc;
}
template <int MODE, bool OUT32>
__device__ __forceinline__ void mini_seam(Frame& F, const bf16* A, const bf16* Bt, int K, int unit, const float* xs, bf16* ZA, float* Z32, const float* st_in, const LAS float* gb_lds, float* st_out) {
    const int mb = unit >> 3, nb = unit & 7;
    const mini_f32x16 acc = mini_acc(F, A, Bt, K, mb, nb);
    const int lane = flane(), wid = F.wave, r32 = lane & 31, hi = lane >> 5, wm = wid & 1, wn = wid >> 1;
    const int row = MP + 64 * mb + 32 * wm + r32;
    const int c0 = 128 * nb + 32 * wn + 4 * hi; const float alpha = ALPHA;
    float mu = 0.f, rstd = 1.f;
    if (MODE == 1) { const float sm = st_in[2 * (size_t)row], sq2 = st_in[2 * (size_t)row + 1]; mu = sm * (1.0f / D); rstd = 1.0f / sqrtf(fmaxf(sq2 * (1.0f / D) - mu * mu, 0.f) + LN_EPS); }
    f32x4 res[4];
#pragma unroll
    for (int g = 0; g < 4; ++g) { const size_t o = (size_t)row * D + c0 + 8 * g;
        if (MODE == 0) res[g] = *(const GAS f32x4*)(xs + (o - (size_t)MP * D));
        else { const unsigned long long w = *(const GAS unsigned long long*)(ZA + o); const unsigned lo = (unsigned)w, hh = (unsigned)(w >> 32);
            const f32x4 zp = {__builtin_bit_cast(float, lo << 16), __builtin_bit_cast(float, lo & 0xffff0000u), __builtin_bit_cast(float, hh << 16), __builtin_bit_cast(float, hh & 0xffff0000u)};
            if (MODE == 2) res[g] = zp; else res[g] = (zp - mu) * rstd * *(const LAS f32x4*)(gb_lds + c0 + 8 * g) + *(const LAS f32x4*)(gb_lds + 1024 + c0 + 8 * g); } }
    asm volatile("" ::: "memory");
    float sacc = 0.f, qacc = 0.f;
#pragma unroll
    for (int g = 0; g < 4; ++g) { const size_t o = (size_t)row * D + c0 + 8 * g; const f32x4 z = res[g] * alpha + (f32x4){acc[4 * g], acc[4 * g + 1], acc[4 * g + 2], acc[4 * g + 3]};
        if (OUT32) *(GAS f32x4*)(Z32 + o) = z; else *(GAS unsigned long long*)(ZA + o) = (unsigned long long)pk2(z[0], z[1]) | ((unsigned long long)pk2(z[2], z[3]) << 32);
        sacc += (z[0] + z[1]) + (z[2] + z[3]); qacc += (z[0] * z[0] + z[1] * z[1]) + (z[2] * z[2] + z[3] * z[3]); }
    if (st_out) { sacc += __shfl_xor(sacc, 32); qacc += __shfl_xor(qacc, 32); if (hi == 0) { atomicAdd(st_out + 2 * (size_t)row, sacc); atomicAdd(st_out + 2 * (size_t)row + 1, qacc); } }
}

__device__ __forceinline__ void mini_ino(Frame& F, const bf16* A, const bf16* Bt, int unit, bf16* U, bf16* VB, const float* st, const float* G, const float* Bv, float* stv) {
    const int mb = unit >> 4, nb = unit & 15;
    const mini_f32x16 acc = mini_acc(F, A, Bt, D, mb, nb);
    const int lane = flane(), wid = F.wave, r32 = lane & 31, hi = lane >> 5, wm = wid & 1, wn = wid >> 1;
    const int row = MP + 64 * mb + 32 * wm + r32; const int c0 = 128 * nb + 32 * wn + 4 * hi; const bool isu = nb < 8;
    const pg8::f32x2 sq = *(const GAS pg8::f32x2*)(st + 2 * (size_t)row); const float mu = sq.x * (1.0f / D); const float rstd = 1.0f / sqrtf(fmaxf(sq.y * (1.0f / D) - mu * mu, 0.f) + LN_EPS);
    f32x4 gq[4], bq[4];
#pragma unroll
    for (int g = 0; g < 4; ++g) { gq[g] = *(const GAS f32x4*)(G + c0 + 8 * g); bq[g] = *(const GAS f32x4*)(Bv + c0 + 8 * g); }
    float sacc = 0.f, qacc = 0.f; bf16* dst = (isu ? U : VB) + (size_t)row * D + (c0 & 1023);
#pragma unroll
    for (int g = 0; g < 4; ++g) { const f32x4 a4 = {acc[4 * g], acc[4 * g + 1], acc[4 * g + 2], acc[4 * g + 3]}; const f32x4 v = pg8::gelu4((a4 - mu * gq[g]) * rstd + bq[g]);
        *(GAS unsigned long long*)(dst + 8 * g) = (unsigned long long)pk2(v[0], v[1]) | ((unsigned long long)pk2(v[2], v[3]) << 32);
        sacc += (v[0] + v[1]) + (v[2] + v[3]); qacc += (v[0] * v[0] + v[1] * v[1]) + (v[2] * v[2] + v[3] * v[3]); }
    if (!isu) { sacc += __shfl_xor(sacc, 32); qacc += __shfl_xor(qacc, 32); if (hi == 0) { atomicAdd(stv + 2 * (size_t)row, sacc); atomicAdd(stv + 2 * (size_t)row + 1, qacc); } }
}

__device__ __forceinline__ void final_ln_phase(Frame& F, const float* Z, const float* g, const float* bta) {
    const int gw = F.vcu * NWAVES + F.wave, NGW = F.G * NWAVES, lane = flane();
    f32x4 gv[4], bv[4];
#pragma unroll
    for (int j = 0; j < 4; ++j) { gv[j] = ((const GAS f32x4*)g)[lane + 64 * j]; bv[j] = ((const GAS f32x4*)bta)[lane + 64 * j]; }
    f32x4 vn[4];
    if (gw < M) { const GAS f32x4* zr = (const GAS f32x4*)(Z + (size_t)gw * D) + lane;
#pragma unroll
        for (int j = 0; j < 4; ++j) vn[j] = zr[64 * j]; }
    for (int m = gw; m < M; m += NGW) {
        float* orow = m < MP ? F.out + O_YP + (size_t)m * D : F.out + O_YS + (size_t)(m - MP) * D;
        f32x4 v[4]; float s = 0.f;
#pragma unroll
        for (int j = 0; j < 4; ++j) { v[j] = vn[j]; s += (v[j].x + v[j].y) + (v[j].z + v[j].w); }
        if (m + NGW < M) { const GAS f32x4* zr = (const GAS f32x4*)(Z + (size_t)(m + NGW) * D) + lane;
#pragma unroll
            for (int j = 0; j < 4; ++j) vn[j] = zr[64 * j]; }
        const float mean = wave_sum(s) * (1.f / D); float s2 = 0.f;
#pragma unroll
        for (int j = 0; j < 4; ++j) { v[j] = v[j] - mean; s2 += (v[j].x * v[j].x + v[j].y * v[j].y) + (v[j].z * v[j].z + v[j].w * v[j].w); }
        const float rstd = 1.f / sqrtf(wave_sum(s2) * (1.f / D) + LN_EPS);
        GAS f32x4* o4 = (GAS f32x4*)orow + lane;
#pragma unroll
        for (int j = 0; j < 4; ++j) __builtin_nontemporal_store(v[j] * rstd * gv[j] + bv[j], (f32x4*)(o4 + 64 * j));
    }
}
__device__ __forceinline__ void sgu_phase(Frame& F) {
    constexpr int PITCH = 136;
    LAS bf16* vT = (LAS bf16*)(F.lds + RING_OFF); LAS bf16* wT = vT + 128 * PITCH;
    const bf16* VN = (const bf16*)(F.ws + WS_VN); const bf16* U = (const bf16*)(F.ws + WS_U); bf16* G = (bf16*)(F.ws + WS_G); const float* STV = (const float*)(F.ctl + CW_STAT) + (size_t)3 * M * 2;
    const int tid = ftid(F), lane = flane(), wid = F.wave, fr = lane & 15, fq = lane >> 4;
    const int g = F.vcu & 7;
    for (int e = tid; e < 128 * 32; e += 512) { const int t = e >> 5, s4 = (e & 31) * 4; f32x4 w = *(const GAS f32x4*)(INP(I_SGW) + ((size_t)g * 128 + t) * 128 + s4);
        w.x = s4 + 0 <= t ? w.x : 0.f; w.y = s4 + 1 <= t ? w.y : 0.f; w.z = s4 + 2 <= t ? w.z : 0.f; w.w = s4 + 3 <= t ? w.w : 0.f;
        *(LAS unsigned long long*)(wT + t * PITCH + s4) = (unsigned long long)pk2(w.x, w.y) | ((unsigned long long)pk2(w.z, w.w) << 32); }
    for (int ci = F.vcu >> 3; ci < 128 + 32; ci += (F.G >> 3)) { const int L = ci < 128 ? 128 : 64; const int row0 = ci < 128 ? ci * 128 : MP + (ci - 128) * 64;
        { const int c8 = (tid & 15) * 8;
          const GAS f32x4* gp = (const GAS f32x4*)(INP(I_SGG) + g * 128 + c8); const GAS f32x4* bp = (const GAS f32x4*)(INP(I_SGB) + g * 128 + c8); const f32x4 g0 = gp[0], g1 = gp[1], b0 = bp[0], b1 = bp[1];
          for (int s = (tid >> 4) * 2; s < L; s += 64) {
            float v[2][8];
#pragma unroll
            for (int k2 = 0; k2 < 2; ++k2) { const int row = row0 + s + k2; unpack8(*(const GAS v4u*)(VN + (size_t)row * D + g * 128 + c8), v[k2]);
                const pg8::f32x2 sq2 = *(const GAS pg8::f32x2*)(STV + 2 * (size_t)row); const float mu = sq2.x * (1.0f / D); const float rstd = 1.0f / sqrtf(fmaxf(sq2.y * (1.0f / D) - mu * mu, 0.f) + LN_EPS);
#pragma unroll
                for (int i = 0; i < 4; ++i) { v[k2][i] = (v[k2][i] - mu) * rstd * g0[i] + b0[i]; v[k2][4 + i] = (v[k2][4 + i] - mu) * rstd * g1[i] + b1[i]; }
                if (row >= MP) { GAS f32x4* op = (GAS f32x4*)(F.out + O_SGV + (size_t)(row - MP) * D + g * 128 + c8); op[0] = (f32x4){v[k2][0], v[k2][1], v[k2][2], v[k2][3]}; op[1] = (f32x4){v[k2][4], v[k2][5], v[k2][6], v[k2][7]}; } }
#pragma unroll
            for (int i = 0; i < 8; ++i) *(LAS unsigned*)(vT + (c8 + i) * PITCH + s) = pk2(v[0][i], v[1][i]); } }
        __syncthreads();
        bf16x8 af[4];
#pragma unroll
        for (int ks = 0; ks < 4; ++ks) af[ks] = (ks * 32 < L) ? *(const LAS bf16x8*)(vT + (16 * wid + fr) * PITCH + ks * 32 + fq * 8) : (bf16x8){0, 0, 0, 0, 0, 0, 0, 0};
        unsigned long long uu8[8]; float bs8[8];
#pragma unroll
        for (int j = 0; j < 8; ++j) if (16 * j < L) { const int t = 16 * j + fr; bs8[j] = INP(I_SGBIAS)[g * 128 + t]; uu8[j] = *(const GAS unsigned long long*)(U + (size_t)(row0 + t) * D + g * 128 + 16 * wid + 4 * fq); }
#pragma unroll
        for (int j = 0; j < 8; ++j) if (16 * j < L) { f32x4 acc = {0.f, 0.f, 0.f, 0.f}; const int nk = ((16 * j + 15) >> 5) + 1;
#pragma unroll
            for (int ks = 0; ks < 4; ++ks) if (ks < nk) { const bf16x8 bfr = *(const LAS bf16x8*)(wT + (16 * j + fr) * PITCH + ks * 32 + fq * 8); acc = __builtin_amdgcn_mfma_f32_16x16x32_bf16(af[ks], bfr, acc, 0, 0, 0); }
            const int t = 16 * j + fr; const float bs = bs8[j]; const size_t o = (size_t)(row0 + t) * D + g * 128 + 16 * wid + 4 * fq;
            const unsigned long long uu = uu8[j]; const unsigned ulo = (unsigned)uu, uhi = (unsigned)(uu >> 32);
            const float r0 = __builtin_bit_cast(float, ulo << 16) * (acc[0] + bs), r1 = __builtin_bit_cast(float, ulo & 0xffff0000u) * (acc[1] + bs), r2 = __builtin_bit_cast(float, uhi << 16) * (acc[2] + bs), r3 = __builtin_bit_cast(float, uhi & 0xffff0000u) * (acc[3] + bs);
            *(GAS unsigned long long*)(G + o) = (unsigned long long)pk2(r0, r1) | ((unsigned long long)pk2(r2, r3) << 32); }
        __syncthreads(); }
}
#ifndef MK_N_LAUNCHES
#define MK_N_LAUNCHES 1
#endif
constexpr int PER_PHASE = 19;
constexpr int N_LAUNCHES = MK_N_LAUNCHES;
__device__ __attribute__((aligned(16))) unsigned g_bar_words[XCD_BAR_WORDS + 64];
struct Args { const float* in[32]; float* out; unsigned char* ws; int ph_lo, ph_hi, li, pad; };
static_assert(sizeof(Args) == 32 * 8 + 8 + 8 + 16, "Args has no padding bytes");

__global__ void __launch_bounds__(NWAVES * 64, 2) fwd_kernel(Args args) {
    extern __shared__ __attribute__((aligned(16))) unsigned char lds[];
    Frame F;
    F.lds = (LAS unsigned char*)lds;
    F.MISC = (volatile LAS unsigned*)(F.lds + MISC_OFF);
    F.wave = __builtin_amdgcn_readfirstlane((int)threadIdx.x >> 6);
    F.G = gridDim.x; { const int bx = blockIdx.x; F.vcu = (F.G % 8 == 0) ? (bx % 8) * (F.G / 8) + bx / 8 : bx; }
    F.out = args.out; F.ws = args.ws; F.ctl = (gu32*)(args.ws + WS_CTL);
    unsigned char* ws = args.ws;
    for (int u = ftid(F); u < (LDS_BYTES - LDSCTL_OFF) / 4; u += NWAVES * 64) ((LAS unsigned*)(F.lds + LDSCTL_OFF))[u] = 0u;
    __syncthreads();
    XcdBarrier bar; bar.bar = g_bar_words; bar.x = 0; bar.st = nullptr; bar.wave = 1;
    if (N_LAUNCHES != PER_PHASE) bar = xcd_barrier_post(g_bar_words, F.MISC + 8, F.wave);
#define GRID_BAR(seam) do { if (N_LAUNCHES == PER_PHASE) { if (ftid(F) == 0) __hip_atomic_store(F.ctl + CW_TMO, 0xBADBA0u | (unsigned)(seam), RLX_AGENT); } else { xcd_barrier(bar); } } while (0)
    const int lo = args.ph_lo, hi = args.ph_hi;
#define IN(k) (lo <= (k) && (k) < hi)
#define SEAM(k) do { if (IN(k) && IN((k) + 1)) GRID_BAR(k); } while (0)
#define RUN(k, ...) if (IN(k)) { { __VA_ARGS__ } SEAM(k); }
    bf16* XA = (bf16*)(ws + WS_XA); float* XR = (float*)(ws + WS_XR); bf16* ACT = (bf16*)(ws + WS_ACT);
    float* out = args.out;
    const int cblk = (int)blockIdx.x;

    float* const ST0 = (float*)(F.ctl + CW_STAT); float* const ST1 = ST0 + (size_t)M * 2; float* const ST2 = ST1 + (size_t)M * 2;
    const float* const GV = (const float*)(ws + WS_GBV); const float* const BV = GV + NVEC;
    RUN(0, p0_prologue(F);)
    RUN(1, pg8::Gemm g{XA, (const bf16*)(ws + WS_WINE), M, NE, D}; pg8::StaticOrder S; S.init(M, NE, F.G, cblk);
        pg8::EpiInE E{(bf16*)(ws + WS_Q), (bf16*)(ws + WS_K), (bf16*)(ws + WS_V), (bf16*)(ws + WS_XB), (bf16*)(ws + WS_GB), out + O_KP, out + O_VP, out + O_KS, out + O_VS, out + O_RCP, out + O_RCS, QSCALE};
        pg8::gemm_phase<pg8::EpiInE, pg8::StaticOrder, true, true>(F.lds + RING_OFF, g, S, E, F.wave);
        if (F.G == 256 && cblk >= 208) { p2_scans(F, (cblk - 208) * NWAVES + F.wave, 48 * NWAVES); p2_vecs(F, VEC_UP0, VEC_UP0 + FF2, (cblk - 208) * 512 + ftid(F), 48 * 512); }
        else if (F.G != 256) { p2_scans(F, F.vcu * NWAVES + F.wave, F.G * NWAVES); p2_vecs(F, 0, NVEC, F.vcu * 512 + ftid(F), F.G * 512); })
    RUN(2, p2_norms(F); for (int it = F.vcu * NWAVES + F.wave; it < 2048; it += F.G * NWAVES) rg_wave_item(F, it, 1); __syncthreads();)
    RUN(3, p3_mixer(F);)
    RUN(4, pg8::Gemm g{(const bf16*)(ws + WS_MIX), (const bf16*)(ws + WS_WOUTE), MP, D, D}; pg8::StaticOrder S; S.init(MP, D, F.G, cblk);
        pg8::EpiRes<0, false> E{INP(I_XP), INP(I_XS), XA, nullptr, nullptr, nullptr, ST0};
        pg8::gemm_phase<pg8::EpiRes<0, false>, pg8::StaticOrder, true, true>(F.lds + RING_OFF, g, S, E, F.wave);
        for (int mu_ = cblk; mu_ < 256; mu_ += F.G) mini_seam<0, false>(F, (const bf16*)(ws + WS_MIX), (const bf16*)(ws + WS_WOUTE), D, mu_, INP(I_XS), XA, nullptr, nullptr, nullptr, ST0);
        )
    RUN(6, pg8::Gemm g{XA - 2 * D, (const bf16*)(ws + WS_WUP0), 73 * 256, FF2, D, 254}; pg8::StaticOrder S; S.init(73 * 256, FF2, F.G, cblk);
        pg8::EpiUpGate E{ACT, out + O_FCP, out + O_FCS, ST0, GV + VEC_UP0, BV + VEC_UP0, INP(I_FCW), INP(I_FCB), INP(I_SFC), (LAS float*)(F.lds + LDSX_OFF)};
        pg8::gemm_phase<pg8::EpiUpGate, pg8::StaticOrder, true, true>(F.lds + RING_OFF, g, S, E, F.wave);
        if (F.G == 256 && cblk >= 70) { weights_set(F, 1, (cblk - 70) * NWAVES + F.wave, 186 * NWAVES); weights_set(F, 2, (cblk - 70) * NWAVES + F.wave, 186 * NWAVES); })
    RUN(8, pg8::Gemm g{ACT, (const bf16*)(ws + WS_WDN0), MP, D, FF}; pg8::StaticOrder S; S.init(MP, D, F.G, cblk);
        stage_gb(F, INP(I_LMG), INP(I_LMB)); pg8::EpiRes<1, false> E{nullptr, nullptr, XA, nullptr, ST0, (const LAS float*)(F.lds + LDSX_OFF), ST1};
        pg8::gemm_phase<pg8::EpiRes<1, false>, pg8::StaticOrder, true, true>(F.lds + RING_OFF, g, S, E, F.wave);
        for (int mu_ = cblk; mu_ < 256; mu_ += F.G) mini_seam<1, false>(F, ACT, (const bf16*)(ws + WS_WDN0), FF, mu_, nullptr, XA, nullptr, ST0, (const LAS float*)(F.lds + LDSX_OFF), ST1);
        if (F.G == 256) { p2_vecs(F, VEC_INO, VEC_INO + 2 * D, F.vcu * 512 + ftid(F), F.G * 512); p2_vecs(F, VEC_UP1, VEC_UP1 + FF2, F.vcu * 512 + ftid(F), F.G * 512); })
    RUN(10, pg8::Gemm g{XA, (const bf16*)(ws + WS_WINO), MP, 2 * D, D}; pg8::StaticOrder S; S.init(MP, 2 * D, F.G, cblk); pg8::EpiInO E{(bf16*)(ws + WS_U), (bf16*)(ws + WS_VN), ST1, GV + VEC_INO, BV + VEC_INO, ST2 + (size_t)M * 2};
        pg8::gemm_phase<pg8::EpiInO, pg8::StaticOrder, true, true>(F.lds + RING_OFF, g, S, E, F.wave);
        for (int mu_ = cblk; mu_ < 512; mu_ += F.G) mini_ino(F, XA, (const bf16*)(ws + WS_WINO), mu_, (bf16*)(ws + WS_U), (bf16*)(ws + WS_VN), ST1, GV + VEC_INO, BV + VEC_INO, ST2 + (size_t)M * 2);)
    RUN(12, sgu_phase(F);)
    RUN(13, pg8::Gemm g{(const bf16*)(ws + WS_G), (const bf16*)(ws + WS_WOUTO), MP, D, D}; pg8::StaticOrder S; S.init(MP, D, F.G, cblk);
        stage_gb(F, INP(I_LFG), INP(I_LFB)); pg8::EpiRes<1, false> E{nullptr, nullptr, XA, nullptr, ST1, (const LAS float*)(F.lds + LDSX_OFF), ST2};
        pg8::gemm_phase<pg8::EpiRes<1, false>, pg8::StaticOrder, true, true>(F.lds + RING_OFF, g, S, E, F.wave);
        for (int mu_ = cblk; mu_ < 256; mu_ += F.G) mini_seam<1, false>(F, (const bf16*)(ws + WS_G), (const bf16*)(ws + WS_WOUTO), D, mu_, nullptr, XA, nullptr, ST1, (const LAS float*)(F.lds + LDSX_OFF), ST2);
        )
    RUN(15, pg8::Gemm g{XA - 2 * D, (const bf16*)(ws + WS_WUP1), 73 * 256, FF2, D, 254}; pg8::StaticOrder S; S.init(73 * 256, FF2, F.G, cblk);
        pg8::EpiUpGate E{ACT, out + O_FCP + (size_t)NBP * 2 * FF2, out + O_FCS + (size_t)NBS * 2 * FF2, ST2, GV + VEC_UP1, BV + VEC_UP1, INP(I_FCW) + 3 * FF2, INP(I_FCB) + FF2, INP(I_SFC) + (size_t)NBS * 2 * FF2, (LAS float*)(F.lds + LDSX_OFF)};
        pg8::gemm_phase<pg8::EpiUpGate, pg8::StaticOrder, true, true>(F.lds + RING_OFF, g, S, E, F.wave);)
    RUN(17, pg8::Gemm g{ACT, (const bf16*)(ws + WS_WDN1), MP, D, FF}; pg8::StaticOrder S; S.init(MP, D, F.G, cblk);
        stage_gb(F, INP(I_LMG) + D, INP(I_LMB) + D); pg8::EpiRes<1, true> E{nullptr, nullptr, XA, XR, ST2, (const LAS float*)(F.lds + LDSX_OFF), nullptr};
        pg8::gemm_phase<pg8::EpiRes<1, true>, pg8::StaticOrder, true, true>(F.lds + RING_OFF, g, S, E, F.wave);
        for (int mu_ = cblk; mu_ < 256; mu_ += F.G) mini_seam<1, true>(F, ACT, (const bf16*)(ws + WS_WDN1), FF, mu_, nullptr, XA, XR, ST2, (const LAS float*)(F.lds + LDSX_OFF), nullptr);)
    if (IN(18)) { final_ln_phase(F, XR, INP(I_LFG) + D, INP(I_LFB) + D); }
    if (N_LAUNCHES != PER_PHASE) {
        __syncthreads();
        if (ftid(F) == 0) { const unsigned done = __hip_atomic_fetch_add(g_bar_words + XCD_BAR_WORDS, 1u, __ATOMIC_RELAXED, __HIP_MEMORY_SCOPE_AGENT); F.MISC[12] = (done + 1u == (unsigned)F.G) ? 1u : 0u; }
        __syncthreads();
        if (F.MISC[12] != 0u) { for (int i = ftid(F); i < (XCD_BAR_WORDS + 64) / 4; i += NWAVES * 64) ((GAS v4u*)g_bar_words)[i] = (v4u){0u, 0u, 0u, 0u}; }
    }
#undef IN
#undef SEAM
}

extern "C" void kernel_launch(void* const* d_in, const int* in_sizes, int n_in, void* d_out, int out_size, void* d_ws, size_t ws_size, hipStream_t stream) {
    static int grid = 0;
    if (grid == 0) {
        if (n_in != N_IN || (size_t)out_size != O_END || ws_size < WS_END) { fprintf(stderr, "kernel_launch: built for %d inputs, %zu outputs, >= %zu bytes of workspace; got n_in %d, out %d, ws %zu; nothing launched\n", (int)N_IN, (size_t)O_END, (size_t)WS_END, n_in, out_size, ws_size); grid = -1; return; }
        int dev = 0, cus = 0, per_cu = 0;
        if (hipGetDevice(&dev) != hipSuccess || hipDeviceGetAttribute(&cus, hipDeviceAttributeMultiprocessorCount, dev) != hipSuccess) { fprintf(stderr, "kernel_launch: device query failed\n"); grid = -1; return; }
        if (hipFuncSetAttribute((const void*)fwd_kernel, hipFuncAttributeMaxDynamicSharedMemorySize, LDS_BYTES) != hipSuccess) { fprintf(stderr, "kernel_launch: hipFuncSetAttribute failed\n"); grid = -1; return; }
        if (hipOccupancyMaxActiveBlocksPerMultiprocessor(&per_cu, (const void*)fwd_kernel, NWAVES * 64, LDS_BYTES) != hipSuccess || per_cu < 1)
            fprintf(stderr, "kernel_launch: note: occupancy query reports %d workgroups per CU\n", per_cu);
        (void)hipGetLastError();
        grid = cus;
    }
    if (grid < 0) return;
    if (N_LAUNCHES == PER_PHASE) { if (hipMemsetAsync((char*)d_ws + WS_CTL, 0, 32768, stream) != hipSuccess) { fprintf(stderr, "kernel_launch: hipMemsetAsync failed\n"); return; } }
    Args a{};
    for (int i = 0; i < 32; ++i) a.in[i] = (const float*)d_in[i];
    a.out = (float*)d_out; a.ws = (unsigned char*)d_ws;
    for (int li = 0; li < N_LAUNCHES; ++li) {
        a.ph_lo = (N_LAUNCHES == PER_PHASE) ? li : 0; a.ph_hi = (N_LAUNCHES == PER_PHASE) ? li + 1 : PER_PHASE; a.li = li;
        hipLaunchKernelGGL(fwd_kernel, dim3(grid), dim3(NWAVES * 64), LDS_BYTES, stream, a);
        const hipError_t le = hipPeekAtLastError();
        if (le != hipSuccess) { fprintf(stderr, "kernel_launch: launch %d failed: %s\n", li, hipGetErrorName(le)); break; }
    }
}
```
